# Optimizing an MI355X kernel written in HIP

```python
import math
import jax, jax.numpy as jnp
from jax import lax
import numpy as np

D_MODEL = 1024
BATCH = 4
SEQ = 8192
DEPTH = 1

CHUNK = 64
NORM_EPS = 1e-5
SB_HEADS = 8
SB_HEAD_DIM = 64
SB_WIDTH = SB_HEADS * SB_HEAD_DIM
Q_BLOCK = 128
POOL_WINDOWS = (2, 4, 8, 16)
POOL_GROUPS = len(POOL_WINDOWS)
POOL_GROUP_DIM = 128
POOL_WIDTH = POOL_GROUPS * POOL_GROUP_DIM
MIX_WIDTH = SB_WIDTH + POOL_WIDTH
IN_PROJ_WIDTH = 3 * SB_WIDTH + POOL_WIDTH
N_EXPERTS = 32
TOP_K = 4
D_FF = D_MODEL
SWIGLU_LIMIT = 7.0
SWIGLU_ALPHA = 1.702
EXPERT_BLOCK = 256

kernel_name = "stickbreak_pool_hybrid_moe"


def rms_norm(x, g):
    xf = x.astype(jnp.float32)
    y = xf * lax.rsqrt(jnp.mean(xf * xf, axis=-1, keepdims=True) + NORM_EPS)
    return (y * g.astype(jnp.float32)).astype(x.dtype)


def stick_breaking_attention(q, k, v):
    B, S, H, dh = q.shape
    scale = 1.0 / math.sqrt(dh)
    qh = q.transpose(0, 2, 1, 3).astype(jnp.float32)
    kh = k.transpose(0, 2, 1, 3).astype(jnp.float32)
    vh = v.transpose(0, 2, 1, 3).astype(jnp.float32)
    n_blocks = S // Q_BLOCK
    q_blocks = qh.reshape(B, H, n_blocks, Q_BLOCK, dh).transpose(2, 0, 1, 3, 4)
    starts = jnp.arange(n_blocks, dtype=jnp.int32) * Q_BLOCK
    key_pos = jnp.arange(S, dtype=jnp.int32)[None, :]

    def one_block(args):
        q_blk, t0 = args
        z = jnp.einsum('bhqd,bhkd->bhqk', q_blk, kh) * scale
        qry_pos = t0 + jnp.arange(Q_BLOCK, dtype=jnp.int32)[:, None]
        past = key_pos < qry_pos
        log_keep = jnp.where(past, jax.nn.log_sigmoid(-z), 0.0)
        after = lax.cumsum(log_keep, axis=3, reverse=True) - log_keep
        a = jnp.where(past, jnp.exp(jax.nn.log_sigmoid(z) + after), 0.0)
        return jnp.einsum('bhqk,bhkd->bhqd', a, vh)

    out = lax.map(one_block, (q_blocks, starts))
    out = out.transpose(1, 0, 3, 2, 4).reshape(B, S, H, dh)
    return out.astype(q.dtype)


def multiscale_pool(u, w_pool, pool_scale):
    B, S, _ = u.shape
    p = u.reshape(B, S, POOL_GROUPS, POOL_GROUP_DIM).astype(jnp.float32)
    c0 = jnp.concatenate([jnp.zeros((B, 1, POOL_GROUPS, POOL_GROUP_DIM), jnp.float32),
                          jnp.cumsum(p, axis=1)], axis=1)
    win = jnp.array(POOL_WINDOWS, dtype=jnp.int32)
    t = jnp.arange(S, dtype=jnp.int32)[:, None]
    lo = jnp.maximum(t + 1 - win[None, :], 0)
    cnt = (t + 1 - lo).astype(jnp.float32)
    lower = c0[:, lo, jnp.arange(POOL_GROUPS)[None, :], :]
    mix = (c0[:, 1:] - lower) / cnt[None, :, :, None] - p
    y = jnp.einsum('bsgc,gcd->bsgd', mix, w_pool.astype(jnp.float32))
    y = y * pool_scale.astype(jnp.float32)
    return y.reshape(B, S, POOL_WIDTH).astype(u.dtype)


def expert_ffn(xb, e, w_gate_up, b_gate_up, w_down, b_down):
    gu = xb @ w_gate_up[e] + b_gate_up[e]
    gate = jnp.minimum(gu[:, :D_FF], SWIGLU_LIMIT)
    up = jnp.clip(gu[:, D_FF:], -SWIGLU_LIMIT, SWIGLU_LIMIT)
    h = (up + 1.0) * gate * jax.nn.sigmoid(SWIGLU_ALPHA * gate)
    return h @ w_down[e] + b_down[e]


def moe_ffn(h, w_router, b_router, w_gate_up, b_gate_up, w_down, b_down):
    B, S, D = h.shape
    n_tok = B * S
    xf = h.reshape(n_tok, D)
    logits = (xf @ w_router + b_router).astype(jnp.float32)
    top_val, top_idx = lax.top_k(logits, TOP_K)
    gates = jax.nn.softmax(top_val, axis=-1)
    n_assign = n_tok * TOP_K
    flat_e = top_idx.reshape(-1).astype(jnp.int32)
    flat_tok = jnp.arange(n_assign, dtype=jnp.int32) // TOP_K
    order = jnp.argsort(flat_e)
    se, stok, sgate = flat_e[order], flat_tok[order], gates.reshape(-1)[order]
    counts = jnp.bincount(flat_e, length=N_EXPERTS)
    padded = (counts + EXPERT_BLOCK - 1) // EXPERT_BLOCK * EXPERT_BLOCK
    start = jnp.cumsum(counts) - counts
    pend = jnp.cumsum(padded)
    pstart = pend - padded
    dest = pstart[se] + (jnp.arange(n_assign, dtype=jnp.int32) - start[se])
    n_blocks = -(-n_assign // EXPERT_BLOCK) + N_EXPERTS
    buf = jnp.zeros((n_blocks * EXPERT_BLOCK, D), xf.dtype).at[dest].set(xf[stok])
    block_e = jnp.minimum(
        jnp.searchsorted(pend, jnp.arange(n_blocks, dtype=jnp.int32) * EXPERT_BLOCK, side='right'),
        N_EXPERTS - 1).astype(jnp.int32)
    yb = lax.map(lambda a: expert_ffn(a[0], a[1], w_gate_up, b_gate_up, w_down, b_down),
                 (buf.reshape(n_blocks, EXPERT_BLOCK, D), block_e))
    y_rows = yb.reshape(-1, D)[dest].astype(jnp.float32) * sgate[:, None]
    out = jax.ops.segment_sum(y_rows, stok, num_segments=n_tok)
    return out.reshape(B, S, D).astype(h.dtype)


def setup_inputs(seed: int = 0) -> dict:
    key = jax.random.key(seed)
    ks = jax.random.split(key, 17)
    f32 = jnp.float32
    nrm = lambda k, shape, s: jax.random.normal(k, shape, f32) * s
    L = DEPTH
    return {
        "x": jax.random.normal(ks[0], (BATCH, SEQ, D_MODEL), f32),
        "norm1_g": 1.0 + nrm(ks[1], (L, D_MODEL), 0.02),
        "w_in": nrm(ks[2], (L, D_MODEL, IN_PROJ_WIDTH), D_MODEL ** -0.5),
        "sb_norm_g": 1.0 + nrm(ks[3], (L, SB_WIDTH), 0.02),
        "w_pool": nrm(ks[4], (L, POOL_GROUPS, POOL_GROUP_DIM, POOL_GROUP_DIM), POOL_GROUP_DIM ** -0.5),
        "pool_scale": 1.0 + nrm(ks[5], (L, POOL_GROUPS, POOL_GROUP_DIM), 0.02),
        "w_out": nrm(ks[6], (L, MIX_WIDTH, D_MODEL), MIX_WIDTH ** -0.5),
        "norm2_g": 1.0 + nrm(ks[7], (L, D_MODEL), 0.02),
        "w_router": nrm(ks[8], (L, D_MODEL, N_EXPERTS), D_MODEL ** -0.5),
        "b_router": nrm(ks[9], (L, N_EXPERTS), 0.01),
        "w_gate_up": nrm(ks[10], (L, N_EXPERTS, D_MODEL, 2 * D_FF), D_MODEL ** -0.5),
        "b_gate_up": nrm(ks[11], (L, N_EXPERTS, 2 * D_FF), 0.02),
        "w_down": nrm(ks[12], (L, N_EXPERTS, D_FF, D_MODEL), D_FF ** -0.5),
        "b_down": nrm(ks[13], (L, N_EXPERTS, D_MODEL), 0.02),
        "final_norm_g": 1.0 + nrm(ks[14], (D_MODEL,), 0.02),
    }


def reference(x, norm1_g, w_in, sb_norm_g, w_pool, pool_scale, w_out, norm2_g,
              w_router, b_router, w_gate_up, b_gate_up, w_down, b_down, final_norm_g):
    B, S, _ = x.shape
    for layer in range(DEPTH):
        h = rms_norm(x, norm1_g[layer])
        proj = h @ w_in[layer]
        q = proj[..., :SB_WIDTH].reshape(B, S, SB_HEADS, SB_HEAD_DIM)
        k = proj[..., SB_WIDTH:2 * SB_WIDTH].reshape(B, S, SB_HEADS, SB_HEAD_DIM)
        v = proj[..., 2 * SB_WIDTH:3 * SB_WIDTH].reshape(B, S, SB_HEADS, SB_HEAD_DIM)
        u = proj[..., 3 * SB_WIDTH:]
        sb = stick_breaking_attention(q, k, v)
        sb = rms_norm(sb, sb_norm_g[layer].reshape(SB_HEADS, SB_HEAD_DIM)).reshape(B, S, SB_WIDTH)
        pool = multiscale_pool(u, w_pool[layer], pool_scale[layer])
        x = x + jnp.concatenate([sb, pool], axis=-1) @ w_out[layer]
        h2 = rms_norm(x, norm2_g[layer])
        x = x + moe_ffn(h2, w_router[layer], b_router[layer], w_gate_up[layer],
                        b_gate_up[layer], w_down[layer], b_down[layer])
    return rms_norm(x, final_norm_g)
```

```cpp
#include <hip/hip_runtime.h>
#include <cstdio>
#include <cstdint>

#define LAS __attribute__((address_space(3)))
#define GAS __attribute__((address_space(1)))

#ifndef MK_N_LAUNCHES
#define MK_N_LAUNCHES 1
#endif
#ifndef MOE_FP8
#define MOE_FP8 1
#endif

constexpr int BATCH = 4, SEQ = 8192, M = BATCH * SEQ, D = 1024, NPROJ = 2048, NE = 32, FF = 1024, TOPK = 4;
constexpr int NH = 8, HD = 64, SBW = 512;
constexpr int LISTCAP = M;
constexpr int MAXROWT = (M * TOPK) / 256 + NE;
constexpr float NORM_EPS = 1e-5f;
constexpr int NWAVES = 8;
constexpr int PER_PHASE = 8;

typedef unsigned short bf16_t;
typedef short bf16x8 __attribute__((ext_vector_type(8)));
typedef float f32x4 __attribute__((ext_vector_type(4)));
typedef float f32x16 __attribute__((ext_vector_type(16)));
typedef unsigned u32x4 __attribute__((ext_vector_type(4)));
typedef unsigned u32x2 __attribute__((ext_vector_type(2)));
typedef float f32x2 __attribute__((ext_vector_type(2)));
typedef int i32x4 __attribute__((ext_vector_type(4)));
typedef int i32x8 __attribute__((ext_vector_type(8)));
constexpr int MOE_EB = MOE_FP8 ? 1 : 2;
constexpr float W8_SCALE = 64.0f;

constexpr size_t MiB = 1u << 20;
constexpr size_t WS_CTL = 0, CTL_ZERO_BYTES = 32768;
constexpr size_t WS_WIN = 1 * MiB;
constexpr size_t WS_WOUT = 5 * MiB;
constexpr size_t WS_WPOOL = 7 * MiB;
constexpr size_t WS_WR = 7 * MiB + 512 * 1024;
constexpr size_t WS_WGU = 8 * MiB;
constexpr size_t WS_WD = 136 * MiB;
constexpr size_t WS_X1 = 200 * MiB;
constexpr size_t WS_H2 = 328 * MiB;
constexpr size_t WS_LTOK = 392 * MiB;
constexpr size_t WS_LGATE = 396 * MiB;
constexpr size_t WS_TCODE = 400 * MiB;
constexpr size_t WS_LRSTD = 946 * MiB;
constexpr size_t WS_HMID = 402 * MiB;
constexpr size_t WS_Y = 674 * MiB;
constexpr size_t WS_XN = 402 * MiB;
constexpr size_t WS_PROJ = 466 * MiB;
constexpr size_t WS_MIX = 594 * MiB;
constexpr size_t WS_VT = 674 * MiB;
constexpr size_t WS_END = 950 * MiB;
static_assert(WS_MIX + (size_t)M * D * 2 <= WS_HMID + (size_t)MAXROWT * 256 * 1024 * 2, "overlay inside HMID/Y");
static_assert(WS_HMID + (size_t)MAXROWT * 256 * FF * 2 <= WS_Y && WS_Y + (size_t)MAXROWT * 256 * D * 2 <= WS_END, "ws map");

constexpr int CW_TMO = 0;
constexpr int CW_CNT = 64;
constexpr int CW_BAR = 4096;

constexpr int RING_BYTES = 131072;
constexpr int MISC_OFF = RING_BYTES;
constexpr int LDS_BYTES = 163840;
constexpr int MO_BAR = 0, MO_CNT = 64, MO_TSTART = 192, MO_T = 328, MO_TILEE = 512, MO_RT = 4096;
constexpr int MAXU = 17;
constexpr int MO_BIAS = 30464;
constexpr int MO_IDS = 4096, MO_RS = MO_IDS + MAXU * 256 * 2, MO_TS = MO_RS + MAXU * 256 * 4;
static_assert(MO_TS + 128 <= MO_BIAS && MO_BIAS + 2048 <= LDS_BYTES - RING_BYTES, "LDS misc map");

#define RLX_AGENT __ATOMIC_RELAXED, __HIP_MEMORY_SCOPE_AGENT
__device__ __forceinline__ unsigned f2bf(float f) { unsigned u = __builtin_bit_cast(unsigned, f); return (u + 0x7fffu + ((u >> 16) & 1u)) >> 16; }
__device__ __forceinline__ unsigned pk2(float lo, float hi) { return f2bf(lo) | (f2bf(hi) << 16); }
__device__ __forceinline__ float bf2f(unsigned short b) { return __builtin_bit_cast(float, (unsigned)b << 16); }
__device__ __forceinline__ float bflo(unsigned w) { return __builtin_bit_cast(float, w << 16); }
__device__ __forceinline__ float bfhi(unsigned w) { return __builtin_bit_cast(float, w & 0xffff0000u); }
__device__ __forceinline__ unsigned cvt_pk_bf16(float lo, float hi) { unsigned r; asm volatile("v_cvt_pk_bf16_f32 %0, %1, %2" : "=v"(r) : "v"(lo), "v"(hi)); return r; }
__device__ __forceinline__ unsigned pk4_fp8(float a, float b, float c, float d) { int w = __builtin_amdgcn_cvt_pk_fp8_f32(a, b, 0, false); w = __builtin_amdgcn_cvt_pk_fp8_f32(c, d, w, true); return (unsigned)w; }
__device__ __forceinline__ float wave_sum(float v) {
#pragma unroll
    for (int o = 1; o < 64; o <<= 1) v += __shfl_xor(v, o);
    return v;
}
__device__ __forceinline__ float wave_max(float v) {
#pragma unroll
    for (int o = 1; o < 64; o <<= 1) v = fmaxf(v, __shfl_xor(v, o));
    return v;
}
__device__ __forceinline__ float vmax0(float a) { return __builtin_amdgcn_fmed3f(a, 0.0f, __builtin_inff()); }
__device__ __forceinline__ float xhalf(float v, int hi) { const unsigned u = __builtin_bit_cast(unsigned, v); const auto r = __builtin_amdgcn_permlane32_swap(u, u, false, false);
    return __builtin_bit_cast(float, hi ? r[0] : r[1]); }
__device__ __forceinline__ int crow(int r, int hi) { return (r & 3) + 8 * (r >> 2) + 4 * hi; }

namespace pg8 {
constexpr int BM = 256, BK = 64, HALF = 128, HTB = HALF * BK * 2, STAGE_BYTES = 8 * HTB, NXCD = 8, WGM = 8;
__host__ __device__ __forceinline__ int lds_byte(int r, int c) { const int st = (r >> 4) * 2 + (c >> 5), rr = r & 15, cc = c & 31, ob = rr * 64 + cc * 2; return st * 1024 + (ob ^ (((ob >> 9) & 1) << 5)); }
__host__ __device__ __forceinline__ void stage_rc(int b, int& R, int& C) { const int st = b / 1024, sb = b % 1024, swz = sb ^ (((sb >> 9) & 1) << 5); R = (st >> 1) * 16 + swz / 64; C = (st & 1) * 32 + (swz % 64) / 2; }
__host__ __device__ __forceinline__ int perm32(int rho) { const int n = rho >> 4, i = rho & 15; return 8 * (i >> 2) + 4 * n + (i & 3); }

struct Unit { int pm, pn, pnl, e, rank0, cnt, slot; };
struct Gemm { const bf16_t* A; const bf16_t* Bt; int K; };

__device__ __forceinline__ bool tile_order(long L, int nM, int nN, int& pm, int& pn) {
    const int nwg = nM * nN; if (L >= nwg) return false;
    int wgid = (int)L; { const int q = nwg / NXCD, r = nwg % NXCD, xcd = wgid % NXCD, off = wgid / NXCD; wgid = (xcd < r ? xcd * (q + 1) : r * (q + 1) + (xcd - r) * q) + off; }
    const int nig = WGM * nN, gid = wgid / nig, fm = gid * WGM, gsz = (nM - fm) < WGM ? (nM - fm) : WGM;
    pm = fm + ((wgid % nig) % gsz); pn = (wgid % nig) / gsz; return true;
}
struct DenseOrder {
    int nM, nN, G, c;
    __device__ __forceinline__ bool next(int i, Unit& u) const { int pm, pn; if (!tile_order((long)i * G + c, nM, nN, pm, pn)) return false; u.pm = pm; u.pn = pn; u.pnl = pn; u.e = 0; u.rank0 = 0; u.cnt = 0; u.slot = i; return true; }
    __device__ __forceinline__ unsigned arow(const Unit& u, int r) const { return (unsigned)(u.pm * BM + r); }
};
template <bool GATHER> struct MoeOrder {
    int T, nN, G, c; const LAS int* tile_e; const LAS int* tstart; const LAS int* cnt; const int* list_tok; const LAS unsigned short* ids;
    __device__ __forceinline__ bool next(int i, Unit& u) const {
        int pm, pn; if (!tile_order((long)i * G + c, T, nN, pm, pn)) return false;
        const int e = tile_e[pm]; u.pm = pm; u.pnl = pn; u.e = e; u.pn = e * nN + pn; u.rank0 = (pm - tstart[e]) * BM; u.cnt = cnt[e]; u.slot = i; return true;
    }
    __device__ __forceinline__ unsigned arow(const Unit& u, int r) const {
        if (GATHER) { if (u.slot < MAXU) return (unsigned)ids[u.slot * 256 + r];
            const int rk = u.rank0 + r; return (rk < u.cnt) ? (unsigned)list_tok[(size_t)u.e * LISTCAP + rk] : 0u; }
        return (unsigned)(u.pm * BM + r);
    }
};

struct EpiProj {
    __device__ __forceinline__ void prefetch(const Unit&, int, int, int) const {}
    static __device__ __forceinline__ int brow(int h, int R) { return h * HALF + (R & ~31) + perm32(R & 31); }
    static constexpr bool PERM = true;
    bf16_t* O; bf16_t* VT; LAS unsigned char* stage;
    __device__ __forceinline__ void operator()(const f32x4 (&acc)[2][2][4][2], const Unit& u, int wr, int wc, int fr, int fq) const {
        if (u.pn == 4 || u.pn == 5) {
            const int rowt = u.pm * BM; const int b = rowt / SEQ, post = (rowt % SEQ) >> 5;
            LAS unsigned char* wb = stage + (wr * 4 + wc) * 1024; const int lane = fr + 16 * fq;
#pragma unroll
            for (int ai = 0; ai < 2; ++ai)
#pragma unroll
                for (int mp = 0; mp < 2; ++mp)
#pragma unroll
                    for (int bj = 0; bj < 2; ++bj) {
#pragma unroll
                        for (int mm = 0; mm < 2; ++mm) { const int m = 2 * mp + mm; const f32x4 v0 = acc[ai][bj][m][0], v1 = acc[ai][bj][m][1];
                            const unsigned w0 = cvt_pk_bf16(v0[0], v0[1]), w1 = cvt_pk_bf16(v0[2], v0[3]), w2 = cvt_pk_bf16(v1[0], v1[1]), w3 = cvt_pk_bf16(v1[2], v1[3]);
                            LAS bf16_t* wp = (LAS bf16_t*)(wb + (fq >> 1) * 8192 + (8 * (fq & 1)) * 64 + (16 * mm + fr) * 2);
                            wp[0 * 32] = (bf16_t)w0; wp[1 * 32] = (bf16_t)(w0 >> 16); wp[2 * 32] = (bf16_t)w1; wp[3 * 32] = (bf16_t)(w1 >> 16);
                            wp[4 * 32] = (bf16_t)w2; wp[5 * 32] = (bf16_t)(w2 >> 16); wp[6 * 32] = (bf16_t)w3; wp[7 * 32] = (bf16_t)(w3 >> 16); }
                        asm volatile("" ::: "memory");
                        const int pos32 = post + 4 * ai + 2 * wr + mp; const int h = (u.pn - 4) * 4 + 2 * bj + (wc >> 1);
                        bf16_t* gp = VT + ((size_t)((b * NH + h) * (SEQ / 32) + pos32) * HD + 32 * (wc & 1)) * 32;
#pragma unroll
                        for (int i = 0; i < 2; ++i) { const int dl = (lane >> 2) + 16 * i, c = lane & 3; const u32x4 t = *(const LAS u32x4*)(wb + i * 8192 + (lane >> 2) * 64 + c * 16); *(u32x4*)(gp + dl * 32 + c * 8) = t; }
                        asm volatile("" ::: "memory");
                    }
            return;
        }
        const int row0 = u.pm * BM + wr * 64 + fr; const int col0 = u.pn * BM + wc * 32 + 8 * fq;
        if (u.pn < 2) {
            const float sc = 0.125f * 1.4426950408889634f;
#pragma unroll
            for (int ai = 0; ai < 2; ++ai)
#pragma unroll
                for (int m = 0; m < 4; ++m) { bf16_t* rowp = O + (size_t)(row0 + ai * HALF + m * 16) * NPROJ + col0;
#pragma unroll
                    for (int bj = 0; bj < 2; ++bj) { const f32x4 v0 = acc[ai][bj][m][0] * sc, v1 = acc[ai][bj][m][1] * sc;
                        u32x4 w; w.x = cvt_pk_bf16(v0[0], v0[1]); w.y = cvt_pk_bf16(v0[2], v0[3]); w.z = cvt_pk_bf16(v1[0], v1[1]); w.w = cvt_pk_bf16(v1[2], v1[3]);
                        *(u32x4*)(rowp + bj * HALF) = w; } }
        } else {
#pragma unroll
            for (int ai = 0; ai < 2; ++ai)
#pragma unroll
                for (int m = 0; m < 4; ++m) { bf16_t* rowp = O + (size_t)(row0 + ai * HALF + m * 16) * NPROJ + col0;
#pragma unroll
                    for (int bj = 0; bj < 2; ++bj) { const f32x4 v0 = acc[ai][bj][m][0], v1 = acc[ai][bj][m][1];
                        u32x4 w; w.x = cvt_pk_bf16(v0[0], v0[1]); w.y = cvt_pk_bf16(v0[2], v0[3]); w.z = cvt_pk_bf16(v1[0], v1[1]); w.w = cvt_pk_bf16(v1[2], v1[3]);
                        *(u32x4*)(rowp + bj * HALF) = w; } }
        }
    }
};
struct EpiRes {
    __device__ __forceinline__ void prefetch(const Unit&, int, int, int) const {}
    static constexpr bool PERM = true;
    static __device__ __forceinline__ int brow(int h, int R) { return h * HALF + (R & ~31) + perm32(R & 31); }
    const bf16_t* xn; const float* rms; bf16_t* out;
    __device__ __forceinline__ void operator()(const f32x4 (&acc)[2][2][4][2], const Unit& u, int wr, int wc, int fr, int fq) const {
        const int row0 = u.pm * BM + wr * 64 + fr, col0 = u.pn * BM + wc * 32 + 8 * fq;
        u32x4 xr[2][4][2]; float rrv[2][4];
#pragma unroll
        for (int ai = 0; ai < 2; ++ai)
#pragma unroll
            for (int m = 0; m < 4; ++m) { const size_t off = (size_t)(row0 + ai * HALF + m * 16) * D + col0; rrv[ai][m] = rms[row0 + ai * HALF + m * 16];
                xr[ai][m][0] = *(const u32x4*)(xn + off); xr[ai][m][1] = *(const u32x4*)(xn + off + HALF); }
        asm volatile("" ::: "memory");
#pragma unroll
        for (int ai = 0; ai < 2; ++ai)
#pragma unroll
            for (int m = 0; m < 4; ++m) { const size_t off = (size_t)(row0 + ai * HALF + m * 16) * D + col0; const float rr = rrv[ai][m];
#pragma unroll
                for (int bj = 0; bj < 2; ++bj) { const u32x4 xb = xr[ai][m][bj];
                    const f32x4 b0 = (f32x4){bflo(xb.x), bfhi(xb.x), bflo(xb.y), bfhi(xb.y)} * rr, b1 = (f32x4){bflo(xb.z), bfhi(xb.z), bflo(xb.w), bfhi(xb.w)} * rr;
                    const f32x4 v0 = b0 + acc[ai][bj][m][0], v1 = b1 + acc[ai][bj][m][1];
                    u32x4 w; w.x = cvt_pk_bf16(v0[0], v0[1]); w.y = cvt_pk_bf16(v0[2], v0[3]); w.z = cvt_pk_bf16(v1[0], v1[1]); w.w = cvt_pk_bf16(v1[2], v1[3]);
                    *(u32x4*)(out + off + bj * HALF) = w; } }
    }
};
struct EpiSwiglu {
    static __device__ __forceinline__ int brow(int h, int R) { return h * HALF + (R & ~31) + perm32(R & 31); }
    static constexpr bool PERM = true;
    bf16_t* Hm; const float* bgu; const float* list_rstd; const LAS float* rsl; LAS unsigned char* bring;
    __device__ __forceinline__ void prefetch(const Unit& u, int ui, int wid, int lane) const {
        if (wid == 0) { const float* src = bgu + (size_t)u.e * (2 * FF) + u.pnl * HALF + (lane >= 32 ? FF - 128 : 0) + 4 * lane;
            __builtin_amdgcn_global_load_lds((const unsigned*)src, (LAS unsigned*)(bring + (ui & 1) * 1024), 16, 0, 0); }
    }
    __device__ __forceinline__ void operator()(const f32x4 (&acc)[2][2][4][2], const Unit& u, int wr, int wc, int fr, int fq) const {
        typedef float f32x2 __attribute__((ext_vector_type(2)));
        const int row0 = u.pm * BM + wr * 64 + fr; const int hc0 = u.pnl * HALF + wc * 32 + 8 * fq;
        const LAS float* bg = (const LAS float*)(bring + (u.slot & 1) * 1024) + wc * 32 + 8 * fq; const LAS float* bu = bg + 128;
        const f32x4 bg0 = *(const LAS f32x4*)bg, bg1 = *(const LAS f32x4*)(bg + 4); f32x4 bu0 = *(const LAS f32x4*)bu, bu1 = *(const LAS f32x4*)(bu + 4);
        bu0 += 1.0f; bu1 += 1.0f;
        float rsv[8];
        if (u.slot < MAXU) {
#pragma unroll
            for (int q = 0; q < 8; ++q) rsv[q] = rsl[u.slot * 256 + wr * 64 + fr + (q >> 2) * HALF + (q & 3) * 16];
        } else {
#pragma unroll
            for (int q = 0; q < 8; ++q) { const int rk = u.rank0 + wr * 64 + fr + (q >> 2) * HALF + (q & 3) * 16; rsv[q] = (rk < u.cnt) ? list_rstd[(size_t)u.e * LISTCAP + rk] : 0.0f; }
        }
#pragma unroll
        for (int ai = 0; ai < 2; ++ai)
#pragma unroll
            for (int m = 0; m < 4; ++m) { bf16_t* rowp = Hm + (size_t)(row0 + ai * HALF + m * 16) * FF + hc0; float h[8];
                const float rs = rsv[ai * 4 + m]; const f32x2 rs2 = (f32x2){rs, rs};
#pragma unroll
                for (int n = 0; n < 2; ++n) { const f32x4 av = acc[ai][0][m][n], uv4 = acc[ai][1][m][n], bgn = n ? bg1 : bg0, bun = n ? bu1 : bu0;
#pragma unroll
                    for (int i = 0; i < 4; i += 2) {
                        f32x2 g = (f32x2){av[i], av[i + 1]} * rs2 + (f32x2){bgn[i], bgn[i + 1]}, up = (f32x2){uv4[i], uv4[i + 1]} * rs2 + (f32x2){bun[i], bun[i + 1]};
                        g.x = fminf(g.x, 7.0f); g.y = fminf(g.y, 7.0f);
                        up.x = __builtin_amdgcn_fmed3f(up.x, -6.0f, 8.0f); up.y = __builtin_amdgcn_fmed3f(up.y, -6.0f, 8.0f);
                        const f32x2 t = g * (f32x2){-1.702f * 1.4426950408889634f, -1.702f * 1.4426950408889634f};
                        f32x2 d = (f32x2){__builtin_amdgcn_exp2f(t.x), __builtin_amdgcn_exp2f(t.y)} + (f32x2){1.0f, 1.0f};
                        d.x = __builtin_amdgcn_rcpf(d.x); d.y = __builtin_amdgcn_rcpf(d.y);
                        const f32x2 hv = (g * up) * d;
                        h[n * 4 + i] = hv.x; h[n * 4 + i + 1] = hv.y; } }
                if (MOE_FP8) { u32x2 w; w.x = pk4_fp8(h[0], h[1], h[2], h[3]); w.y = pk4_fp8(h[4], h[5], h[6], h[7]); *(u32x2*)((unsigned char*)Hm + (size_t)(row0 + ai * HALF + m * 16) * FF + hc0) = w; }
                else { u32x4 w; w.x = cvt_pk_bf16(h[0], h[1]); w.y = cvt_pk_bf16(h[2], h[3]); w.z = cvt_pk_bf16(h[4], h[5]); w.w = cvt_pk_bf16(h[6], h[7]);
                *(u32x4*)rowp = w; } }
    }
};
constexpr float Y8_SCALE = 8.0f;
struct EpiDown {
    static constexpr bool PERM = true;
    static __device__ __forceinline__ int brow(int h, int R) { return 64 * (R >> 5) + 16 * ((R >> 2) & 3) + 8 * h + 4 * ((R >> 4) & 1) + (R & 3); }
    unsigned char* Y; const float* bd; LAS unsigned char* bring;
    __device__ __forceinline__ void prefetch(const Unit& u, int ui, int wid, int lane) const {
        if (wid == 0) __builtin_amdgcn_global_load_lds((const unsigned*)(bd + (size_t)u.e * D + u.pnl * BM + 4 * lane), (LAS unsigned*)(bring + (ui & 1) * 1024), 16, 0, 0);
    }
    __device__ __forceinline__ void operator()(const f32x4 (&acc)[2][2][4][2], const Unit& u, int wr, int wc, int fr, int fq) const {
        const int rt0 = wr * 64 + fr; const int col0 = u.pnl * BM + wc * 64 + 16 * fq;
        const LAS float* bp = (const LAS float*)(bring + (u.slot & 1) * 1024) + wc * 64 + 16 * fq;
        const f32x4 bv0 = *(const LAS f32x4*)bp * Y8_SCALE, bv1 = *(const LAS f32x4*)(bp + 4) * Y8_SCALE, bv2 = *(const LAS f32x4*)(bp + 8) * Y8_SCALE, bv3 = *(const LAS f32x4*)(bp + 12) * Y8_SCALE;
#pragma unroll
        for (int ai = 0; ai < 2; ++ai)
#pragma unroll
            for (int m = 0; m < 4; ++m) { const int rl = rt0 + ai * HALF + m * 16;
                const f32x4 v0 = acc[ai][0][m][0] * Y8_SCALE + bv0, v1 = acc[ai][0][m][1] * Y8_SCALE + bv1, v2 = acc[ai][1][m][0] * Y8_SCALE + bv2, v3 = acc[ai][1][m][1] * Y8_SCALE + bv3;
                u32x4 w; w.x = pk4_fp8(v0[0], v0[1], v0[2], v0[3]); w.y = pk4_fp8(v1[0], v1[1], v1[2], v1[3]); w.z = pk4_fp8(v2[0], v2[1], v2[2], v2[3]); w.w = pk4_fp8(v3[0], v3[1], v3[2], v3[3]);
                *(u32x4*)(Y + (size_t)(u.pm * BM + rl) * D + col0) = w; }
    }
};

__device__ __forceinline__ void mfma8(f32x4& c, const i32x8 a, const i32x8 b, const unsigned sa, const unsigned sb) {
    asm volatile("v_mfma_scale_f32_16x16x128_f8f6f4 %0, %1, %2, %0, %3, %4 op_sel_hi:[0,0,0]" : "+v"(c) : "v"(a), "v"(b), "v"(sa), "v"(sb));
}
__device__ __forceinline__ i32x8 cat8(bf16x8 lo, bf16x8 hi) { const i32x4 a = __builtin_bit_cast(i32x4, lo), b = __builtin_bit_cast(i32x4, hi); return __builtin_shufflevector(a, b, 0, 1, 2, 3, 4, 5, 6, 7); }
template <class Epi, class Sched, bool ALIGN_EPI, bool F8 = false>
__device__ __forceinline__ void gemm_phase(LAS unsigned char* lds, const Gemm g, const Sched& S, const Epi& E) {
    const int tid = threadIdx.x, wid = __builtin_amdgcn_readfirstlane(tid >> 6), lane = tid & 63, wr = wid >> 2, wc = wid & 3, fr = lane & 15, fq = lane >> 4;
    const int K = g.K, nt = K / BK;
    int Rst[2]; unsigned cst[2], voffB[2][2];
#pragma unroll
    for (int i = 0; i < 2; ++i) { int R, C; stage_rc(tid * 16 + i * 8192, R, C);
        Rst[i] = R; cst[i] = (unsigned)C * 2u;
#pragma unroll
        for (int h = 0; h < 2; ++h) voffB[h][i] = (unsigned)(Epi::brow(h, R) * K + C) * 2u; }
    const unsigned rowb = (unsigned)K * 2u;
    constexpr unsigned KSTEP = (unsigned)(BK * 2);
    const unsigned hstep = (unsigned)HALF * (unsigned)K * 2u;
    const unsigned tstep = 2u * hstep;
    const __amdgpu_buffer_rsrc_t rsA = __builtin_amdgcn_make_buffer_rsrc((void*)g.A, 0, 0x7fffffff, 0x00020000);
    const __amdgpu_buffer_rsrc_t rsB = __builtin_amdgcn_make_buffer_rsrc((void*)g.Bt, 0, 0x7fffffff, 0x00020000);
    const unsigned ldsw = (unsigned)wid * 1024u;
    const int aoff = lds_byte(wr * 64 + fr, fq * 8), boff = lds_byte(wc * 32 + fr, fq * 8);
#define PG8_SA(b, h) (((b) * 2 + (h)) * HTB)
#define PG8_SB(b, h) ((4 + (b) * 2 + (h)) * HTB)
#define PG8_STAGE_A(bufoff, soff, voff) do { _Pragma("unroll") for (int _i = 0; _i < 2; ++_i) \
        __builtin_amdgcn_raw_ptr_buffer_load_lds(rsA, (LAS unsigned*)(lds + (bufoff) + ldsw + _i * 8192), 16, (voff)[_i], (soff), 0, 0); } while (0)
#define PG8_STAGE_B(bufoff, soff, h) do { _Pragma("unroll") for (int _i = 0; _i < 2; ++_i) \
        __builtin_amdgcn_raw_ptr_buffer_load_lds(rsB, (LAS unsigned*)(lds + (bufoff) + ldsw + _i * 8192), 16, voffB[h][_i], (soff), 0, 0); } while (0)
#define PG8_LDA(dst, b, h) do { _Pragma("unroll") for (int m = 0; m < 4; ++m) _Pragma("unroll") for (int k = 0; k < 2; ++k) dst[m][k] = *(const LAS bf16x8*)(lds + PG8_SA(b, h) + aoff + m * 2048 + k * 1024); } while (0)
#define PG8_LDB(dst, b, h) do { _Pragma("unroll") for (int n = 0; n < 2; ++n) _Pragma("unroll") for (int k = 0; k < 2; ++k) dst[n][k] = *(const LAS bf16x8*)(lds + PG8_SB(b, h) + boff + n * 2048 + k * 1024); } while (0)
#define PG8_MMA(ai, bj, At, Bt) do { __builtin_amdgcn_s_setprio(1); if constexpr (F8) { _Pragma("unroll") for (int m = 0; m < 4; ++m) _Pragma("unroll") for (int n = 0; n < 2; ++n) \
        mfma8(acc[ai][bj][m][n], cat8(Bt[n][0], Bt[n][1]), cat8(At[m][0], At[m][1]), sc_w, sc_a); } \
        else { _Pragma("unroll") for (int m = 0; m < 4; ++m) _Pragma("unroll") for (int n = 0; n < 2; ++n) _Pragma("unroll") for (int k = 0; k < 2; ++k) \
        acc[ai][bj][m][n] = __builtin_amdgcn_mfma_f32_16x16x32_bf16(Bt[n][k], At[m][k], acc[ai][bj][m][n], 0, 0, 0); } __builtin_amdgcn_s_setprio(0); } while (0)
#define PG8_WAIT_V(n) asm volatile("s_waitcnt vmcnt(" #n ")" ::: "memory")
#define PG8_WAIT_L(n) asm volatile("s_waitcnt lgkmcnt(" #n ")" ::: "memory")
#define PG8_BAR __builtin_amdgcn_s_barrier()
#define PG8_SCHED __builtin_amdgcn_sched_barrier(0)
#define PG8_OFFS(o, u) do { _Pragma("unroll") for (int _h = 0; _h < 2; ++_h) _Pragma("unroll") for (int _i = 0; _i < 2; ++_i) o[_h][_i] = S.arow(u, _h * HALF + Rst[_i]) * rowb + cst[_i]; } while (0)
    Unit cur, nxt; int ui = 0;
    if (!S.next(0, cur)) return;
    f32x4 acc[2][2][4][2];
#pragma unroll
    for (int a = 0; a < 2; ++a)
#pragma unroll
        for (int b = 0; b < 2; ++b)
#pragma unroll
            for (int m = 0; m < 4; ++m)
#pragma unroll
                for (int n = 0; n < 2; ++n) acc[a][b][m][n] = (f32x4){0.f, 0.f, 0.f, 0.f};
    bf16x8 At[4][2], B0[2][2], B1[2][2];
    const unsigned sc_w = 0x79797979u, sc_a = 0x7f7f7f7fu;
    unsigned oc[2][2], on[2][2];
    PG8_OFFS(oc, cur);
    unsigned cB = (unsigned)cur.pn * tstep;
    PG8_STAGE_B(PG8_SB(0, 0), cB, 0); PG8_STAGE_B(PG8_SB(0, 1), cB, 1); PG8_STAGE_A(PG8_SA(0, 0), 0u, oc[0]); PG8_STAGE_A(PG8_SA(0, 1), 0u, oc[1]);
    if (wr == 1) PG8_BAR;
    PG8_WAIT_V(2); PG8_BAR;
    PG8_STAGE_B(PG8_SB(1, 0), cB + KSTEP, 0); PG8_STAGE_A(PG8_SA(1, 0), KSTEP, oc[0]); PG8_STAGE_B(PG8_SB(1, 1), cB + KSTEP, 1);
    PG8_WAIT_V(6); PG8_BAR;
    for (;;) {
        E.prefetch(cur, ui, wid, lane);
        const bool has_next = S.next(ui + 1, nxt);
        const unsigned nB = has_next ? (unsigned)nxt.pn * tstep : cB;
        if (has_next) { PG8_OFFS(on, nxt); } else {
#pragma unroll
            for (int h = 0; h < 2; ++h)
#pragma unroll
                for (int i = 0; i < 2; ++i) on[h][i] = oc[h][i]; }
#pragma unroll 1
        for (int t = 0; t < nt; t += 2) {
            const bool last = (t == nt - 2);
            const unsigned a1 = (unsigned)(t + 1) * KSTEP;
            const unsigned a2 = last ? 0u : (unsigned)(t + 2) * KSTEP; const unsigned b2 = last ? nB : cB + (unsigned)(t + 2) * KSTEP;
            const unsigned a3 = a2 + KSTEP; const unsigned b3 = b2 + KSTEP;
            unsigned o2[2][2];
#pragma unroll
            for (int h = 0; h < 2; ++h)
#pragma unroll
                for (int i = 0; i < 2; ++i) o2[h][i] = last ? on[h][i] : oc[h][i];
            PG8_LDB(B0, 0, 0); PG8_LDB(B1, 0, 1); PG8_SCHED; PG8_LDA(At, 0, 0); PG8_STAGE_A(PG8_SA(1, 1), a1, oc[1]);
            PG8_WAIT_V(8); PG8_WAIT_L(0); PG8_BAR; PG8_MMA(0, 0, At, B0); PG8_MMA(0, 1, At, B1); PG8_BAR; PG8_SCHED;
            PG8_LDA(At, 0, 1); PG8_STAGE_B(PG8_SB(0, 0), b2, 0); PG8_STAGE_B(PG8_SB(0, 1), b2, 1); PG8_STAGE_A(PG8_SA(0, 0), a2, o2[0]);
            PG8_WAIT_V(8); PG8_WAIT_L(0); PG8_BAR; PG8_MMA(1, 0, At, B0); PG8_MMA(1, 1, At, B1); PG8_BAR; PG8_SCHED;
            PG8_LDB(B0, 1, 0); PG8_LDB(B1, 1, 1); PG8_SCHED; PG8_LDA(At, 1, 0); PG8_STAGE_A(PG8_SA(0, 1), a2, o2[1]);
            PG8_WAIT_V(8); PG8_WAIT_L(0); PG8_BAR; PG8_MMA(0, 0, At, B0); PG8_MMA(0, 1, At, B1); PG8_BAR; PG8_SCHED;
            PG8_LDA(At, 1, 1); PG8_STAGE_B(PG8_SB(1, 0), b3, 0); PG8_STAGE_B(PG8_SB(1, 1), b3, 1); PG8_STAGE_A(PG8_SA(1, 0), a3, o2[0]);
            PG8_WAIT_V(8); PG8_WAIT_L(0); PG8_BAR; PG8_MMA(1, 0, At, B0); PG8_MMA(1, 1, At, B1); PG8_BAR; PG8_SCHED;
        }
        if constexpr (ALIGN_EPI) { if (wr == 0) PG8_BAR; }
        if constexpr (F8) asm volatile("s_nop 15\n\ts_nop 7" ::: "memory");
        E(acc, cur, wr, wc, fr, fq);
        if (!has_next) break;
#pragma unroll
        for (int a = 0; a < 2; ++a)
#pragma unroll
            for (int b = 0; b < 2; ++b)
#pragma unroll
                for (int m = 0; m < 4; ++m)
#pragma unroll
                    for (int n = 0; n < 2; ++n) acc[a][b][m][n] = (f32x4){0.f, 0.f, 0.f, 0.f};
        cur = nxt; cB = nB; ++ui;
#pragma unroll
        for (int h = 0; h < 2; ++h)
#pragma unroll
            for (int i = 0; i < 2; ++i) oc[h][i] = on[h][i];
        if constexpr (ALIGN_EPI) { if (wr == 1) PG8_BAR; }
    }
    PG8_WAIT_V(0);
    if constexpr (!ALIGN_EPI) { if (wr == 0) PG8_BAR; }
    PG8_BAR;
#undef PG8_SA
#undef PG8_SB
#undef PG8_STAGE_A
#undef PG8_STAGE_B
#undef PG8_LDA
#undef PG8_LDB
#undef PG8_MMA
#undef PG8_WAIT_V
#undef PG8_WAIT_L
#undef PG8_BAR
#undef PG8_SCHED
#undef PG8_OFFS
}
}

#define XB_TMO      128
#define XB_XCNT(j)  (256  + 64 * (j))
#define XB_XSUB(j)  (1280 + 64 * (j))
#define XB_XGEN(j)  (2304 + 64 * (j))
#define XB_TOP      3328
#define XB_TOPGEN   3392
#define XCD_BAR_WORDS 3456
#define XB_SPIN_CAP (1u << 18)

__device__ __forceinline__ unsigned xb_ld(unsigned* p)              { return __hip_atomic_load(p, __ATOMIC_RELAXED, __HIP_MEMORY_SCOPE_AGENT); }
__device__ __forceinline__ unsigned xb_add(unsigned* p, unsigned v) { return __hip_atomic_fetch_add(p, v, __ATOMIC_RELAXED, __HIP_MEMORY_SCOPE_AGENT); }
__device__ __forceinline__ unsigned xb_xcc_id() { return (unsigned)__builtin_amdgcn_s_getreg((3 << 11) | 20) & 0xFu; }
#define XB_SPIN(cond, bar) do { unsigned _sp = 0; while (cond) { __builtin_amdgcn_s_sleep(1); \
    if ((++_sp & 255u) == 0u) { if (xb_ld(&(bar)[XB_TMO])) break; if (_sp > XB_SPIN_CAP) { atomicAdd(&(bar)[XB_TMO], 1u); break; } } } } while (0)

struct XcdBarrier { unsigned* bar; unsigned x; volatile LAS unsigned* st; };

__device__ __forceinline__ XcdBarrier xcd_barrier_post(unsigned* bar, volatile LAS unsigned* st) {
    XcdBarrier b; b.bar = bar; b.x = xb_xcc_id(); b.st = st;
    if (threadIdx.x == 0) (void)xb_add(&bar[XB_XCNT(b.x)], 1u);
    return b;
}
__device__ __forceinline__ void xcd_barrier_complete(unsigned* bar, unsigned x, unsigned& nloc, unsigned& nx) {
    const unsigned G = gridDim.x * gridDim.y * gridDim.z;
    unsigned sum, cnt, mine, sp = 0u;
    for (;;) {
        sum = 0u; cnt = 0u; mine = 0u;
#pragma unroll
        for (unsigned j = 0; j < 16; ++j) { const unsigned c = xb_ld(&bar[XB_XCNT(j)]); sum += c; cnt += (c > 0u) ? 1u : 0u; mine = (j == x) ? c : mine; }
        if (sum == G) break;
        __builtin_amdgcn_s_sleep(1);
        if ((++sp & 255u) == 0u) { if (xb_ld(&bar[XB_TMO])) break; if (sp > XB_SPIN_CAP) { atomicAdd(&bar[XB_TMO], 1u); break; } }
    }
    nloc = mine > 0u ? mine : 1u; nx = cnt > 0u ? cnt : 1u;
}
__device__ __forceinline__ void xcd_barrier(const XcdBarrier& b) {
    asm volatile("s_waitcnt vmcnt(0)" ::: "memory");
    __syncthreads();
    if (threadIdx.x == 0) {
        unsigned* bar = b.bar;
        __builtin_amdgcn_s_waitcnt(0);
        unsigned nloc = b.st[0], nx = b.st[1];
        if (nloc == 0u) { xcd_barrier_complete(bar, b.x, nloc, nx); b.st[0] = nloc; b.st[1] = nx; }
        const unsigned old = xb_add(&bar[XB_XSUB(b.x)], 1u);
        const unsigned gen = old / nloc;
        if (old + 1u == (gen + 1u) * nloc) {
            __builtin_amdgcn_fence(__ATOMIC_RELEASE, "agent");
            asm volatile("s_waitcnt vmcnt(0)" ::: "memory");
            const unsigned og = xb_add(&bar[XB_TOP], 1u);
            const unsigned tg = og / nx;
            if (og + 1u == (tg + 1u) * nx) xb_add(&bar[XB_TOPGEN], 1u);
            else XB_SPIN(xb_ld(&bar[XB_TOPGEN]) == tg, bar);
            __builtin_amdgcn_fence(__ATOMIC_ACQUIRE, "agent");
            xb_add(&bar[XB_XGEN(b.x)], 1u);
            asm volatile("s_waitcnt vmcnt(0)" ::: "memory");
        } else {
            XB_SPIN(xb_ld(&bar[XB_XGEN(b.x)]) == gen, bar);
            __builtin_amdgcn_fence(__ATOMIC_ACQUIRE, "agent");
            asm volatile("s_waitcnt vmcnt(0)" ::: "memory");
        }
    }
    __syncthreads();
}

struct Args {
    const float *x, *norm1_g, *w_in, *sb_norm_g, *w_pool, *pool_scale, *w_out, *norm2_g, *w_router, *b_router, *w_gate_up, *b_gate_up, *w_down, *b_down, *final_g;
    float* out; unsigned char* ws; int ph_lo, ph_hi;
};

__device__ __forceinline__ void p0_transpose_item(const float* W, int N, bf16_t* WT, int K, int k0, int n0, int drow0, LAS float* scr, int lane, const float* kscale = nullptr) {
#pragma unroll 8
    for (int i = 0; i < 32; ++i) { const int kk = 2 * i + (lane >> 5); const float sk = kscale ? kscale[k0 + kk] : 1.0f; scr[kk * 33 + (lane & 31)] = W[(size_t)(k0 + kk) * N + n0 + (lane & 31)] * sk; }
    asm volatile("s_waitcnt lgkmcnt(0)" ::: "memory");
    const int c = lane & 7;
#pragma unroll
    for (int j = 0; j < 4; ++j) { const int n = (lane >> 3) + 8 * j; const LAS float* s = scr + (8 * c) * 33 + n;
        u32x4 o; o.x = pk2(s[0 * 33], s[1 * 33]); o.y = pk2(s[2 * 33], s[3 * 33]); o.z = pk2(s[4 * 33], s[5 * 33]); o.w = pk2(s[6 * 33], s[7 * 33]);
        *(u32x4*)(WT + (size_t)(drow0 + n) * K + k0 + 8 * c) = o; }
    asm volatile("s_waitcnt lgkmcnt(0)" ::: "memory");
}

__device__ __forceinline__ void p0_transpose_item_f8(const float* W, int N, unsigned char* WT, int K, int k0, int n0, int drow0, LAS float* scr, int lane) {
#pragma unroll 8
    for (int i = 0; i < 32; ++i) { const int kk = 2 * i + (lane >> 5); scr[kk * 33 + (lane & 31)] = W[(size_t)(k0 + kk) * N + n0 + (lane & 31)]; }
    asm volatile("s_waitcnt lgkmcnt(0)" ::: "memory");
    const int c = lane & 3;
#pragma unroll
    for (int j = 0; j < 2; ++j) { const int n = (lane >> 2) + 16 * j; const LAS float* s = scr + (16 * c) * 33 + n;
        u32x4 o;
        o.x = pk4_fp8(s[0 * 33] * W8_SCALE, s[1 * 33] * W8_SCALE, s[2 * 33] * W8_SCALE, s[3 * 33] * W8_SCALE); o.y = pk4_fp8(s[4 * 33] * W8_SCALE, s[5 * 33] * W8_SCALE, s[6 * 33] * W8_SCALE, s[7 * 33] * W8_SCALE);
        o.z = pk4_fp8(s[8 * 33] * W8_SCALE, s[9 * 33] * W8_SCALE, s[10 * 33] * W8_SCALE, s[11 * 33] * W8_SCALE); o.w = pk4_fp8(s[12 * 33] * W8_SCALE, s[13 * 33] * W8_SCALE, s[14 * 33] * W8_SCALE, s[15 * 33] * W8_SCALE);
        *(u32x4*)(WT + (size_t)(drow0 + n) * K + k0 + 16 * c) = o; }
    asm volatile("s_waitcnt lgkmcnt(0)" ::: "memory");
}

constexpr int ATT_SLOTS = 19;
__device__ __forceinline__ LAS unsigned char* att_slot(LAS unsigned char* lds, int tile) { const int sl = tile % ATT_SLOTS; return lds + sl * 8192 + (sl >= 16 ? 8192 : 0); }
struct AttKvLds { const LAS unsigned char* bp; int kro, ksw, vro, vsw;
    __device__ __forceinline__ bf16x8 k(int s, int hi) const { return *(const LAS bf16x8*)(bp + kro + (((2 * s + hi) ^ ksw) << 4)); }
    __device__ __forceinline__ u32x2 v(int s, int db, int jj) const { return *(const LAS u32x2*)(bp + vro + db * 2048 + (((2 * s + jj) ^ vsw) << 4)); } };
struct AttKvGlb { const bf16_t* kp; const bf16_t* vp;
    __device__ __forceinline__ bf16x8 k(int s, int) const { return *(const bf16x8*)(kp + 16 * s); }
    __device__ __forceinline__ u32x2 v(int s, int db, int jj) const { return *(const u32x2*)(vp + db * 1024 + (2 * s + jj) * 8); } };
struct AttKf { bf16x8 f[4]; };  struct AttVf { u32x2 f[8]; };  struct AttPb { bf16x8 f[2]; };
template <class KV> __device__ __forceinline__ AttKf att_read_k(const KV& kv, int hi) { AttKf k;
#pragma unroll
    for (int s = 0; s < 4; ++s) k.f[s] = kv.k(s, hi);
    return k; }
template <class KV> __device__ __forceinline__ AttVf att_read_v(const KV& kv) { AttVf v;
#pragma unroll
    for (int s = 0; s < 2; ++s) {
#pragma unroll
        for (int db = 0; db < 2; ++db) { v.f[4 * s + 2 * db] = kv.v(s, db, 0); v.f[4 * s + 2 * db + 1] = kv.v(s, db, 1); } }
    return v; }
__device__ __forceinline__ f32x16 att_qk(const AttKf& k, const bf16x8 (&qf)[4]) {
    f32x16 p;
#pragma unroll
    for (int r = 0; r < 16; ++r) p[r] = 0.f;
#pragma unroll
    for (int s = 0; s < 4; ++s) p = __builtin_amdgcn_mfma_f32_32x32x16_bf16(k.f[s], qf[s], p, 0, 0, 0);
    return p; }
template <bool DIAG> __device__ __forceinline__ AttPb att_weights(const f32x16& p, int r32, int hi, float& run) {
    float kp[16];
#pragma unroll
    for (int r = 0; r < 16; ++r) kp[r] = __builtin_amdgcn_rcpf(1.0f + __builtin_amdgcn_exp2f(p[r]));
    if (DIAG) {
#pragma unroll
        for (int r = 0; r < 16; ++r) kp[r] = (crow(r, hi) < r32) ? kp[r] : 1.0f;
    }
    float gs[4], og[4], aft[4];
#pragma unroll
    for (int g = 0; g < 4; ++g) { kp[4 * g + 2] *= kp[4 * g + 3]; kp[4 * g + 1] *= kp[4 * g + 2]; kp[4 * g] *= kp[4 * g + 1]; gs[g] = kp[4 * g]; og[g] = xhalf(gs[g], hi); }
    float acc_after = run;
#pragma unroll
    for (int g = 3; g >= 0; --g) { aft[g] = hi ? acc_after : (acc_after * og[g]); acc_after *= gs[g] * og[g]; }
    run = acc_after;
    float a[16];
#pragma unroll
    for (int g = 0; g < 4; ++g) { float c = aft[g];
#pragma unroll
        for (int i = 3; i >= 0; --i) { const int r = 4 * g + i; const float ci = aft[g] * kp[r]; a[r] = c - ci; c = ci; } }
    AttPb pb;
#pragma unroll
    for (int s = 0; s < 2; ++s) { u32x4 w; w.x = cvt_pk_bf16(a[8 * s + 0], a[8 * s + 1]); w.y = cvt_pk_bf16(a[8 * s + 2], a[8 * s + 3]); w.z = cvt_pk_bf16(a[8 * s + 4], a[8 * s + 5]); w.w = cvt_pk_bf16(a[8 * s + 6], a[8 * s + 7]);
        pb.f[s] = __builtin_bit_cast(bf16x8, w); }
    return pb; }
__device__ __forceinline__ void att_pv(const AttVf& vf, const AttPb& pb, f32x16& o0, f32x16& o1) {
#pragma unroll
    for (int s = 0; s < 2; ++s) {
#pragma unroll
        for (int db = 0; db < 2; ++db) { const u32x2 va = vf.f[4 * s + 2 * db], vb = vf.f[4 * s + 2 * db + 1];
            u32x4 v; v.x = va.x; v.y = va.y; v.z = vb.x; v.w = vb.y;
            if (db == 0) o0 = __builtin_amdgcn_mfma_f32_32x32x16_bf16(__builtin_bit_cast(bf16x8, v), pb.f[s], o0, 0, 0, 0); else o1 = __builtin_amdgcn_mfma_f32_32x32x16_bf16(__builtin_bit_cast(bf16x8, v), pb.f[s], o1, 0, 0, 0); } } }

template <class Mid> __device__ __forceinline__ void attn_block(const bf16_t* __restrict__ PROJ, const bf16_t* __restrict__ VT, bf16_t* __restrict__ MIX, LAS unsigned char* lds, int bt, int wave, int lane, const Mid& mid) {
    const int c = bt & 7, b = (bt >> 3) & 3, h = bt >> 5;
    const int r32 = lane & 31, hi = lane >> 5;
    const size_t rowbase = (size_t)b * SEQ;
    const bf16_t* ksrc[4]; const bf16_t* vsrc[4];
#pragma unroll
    for (int i = 0; i < 4; ++i) { const int row = 8 * i + (lane >> 3), cc = (lane & 7) ^ ((row >> 1) & 7); ksrc[i] = PROJ + (rowbase + row) * NPROJ + SBW + h * HD + cc * 8;
        const int d = 16 * i + (lane >> 2), p = (lane & 3) ^ ((d >> 2) & 3); vsrc[i] = VT + (size_t)(b * NH + h) * (SEQ / 32) * HD * 32 + d * 32 + p * 8; }
#define ATT_DMA_TILE(j_) do { LAS unsigned char* d_ = att_slot(lds, (j_)); _Pragma("unroll") for (int i_ = 0; i_ < 4; ++i_) { \
        __builtin_amdgcn_global_load_lds((const unsigned*)(ksrc[i_] + (size_t)(j_) * 32 * NPROJ), (LAS unsigned*)(d_ + i_ * 1024), 16, 0, 0); \
        __builtin_amdgcn_global_load_lds((const unsigned*)(vsrc[i_] + (size_t)(j_) * (HD * 32)), (LAS unsigned*)(d_ + 4096 + i_ * 1024), 16, 0, 0); } } while (0)
    AttKvLds kl; kl.kro = r32 * 128; kl.ksw = (r32 >> 1) & 7; kl.vro = 4096 + r32 * 64 + hi * 8; kl.vsw = (r32 >> 2) & 3;
    const int a0 = 32 * c + 24;
    asm volatile("s_waitcnt lgkmcnt(0)" ::: "memory"); __builtin_amdgcn_s_barrier();
    for (int k = wave; k < 12; k += NWAVES) { const int j = a0 - 4 + k; if (j >= 0) ATT_DMA_TILE(j); }
    bf16x8 qf[4], qn[4]; u32x2 pend[8]; bf16_t* pend_op = MIX;
    { const bf16_t* qp = PROJ + (rowbase + (a0 + wave) * 32 + r32) * NPROJ + h * HD + hi * 8;
#pragma unroll
      for (int s = 0; s < 4; ++s) qf[s] = *(const bf16x8*)(qp + 16 * s); }
    mid();
#pragma unroll 1
    for (int n = 0; n < 4; ++n) {
        const int a = a0 - 8 * n, qb = a + wave;
        asm volatile("" ::: "memory");
        __builtin_amdgcn_s_waitcnt(0x0070);
        asm volatile("" ::: "memory");
        __builtin_amdgcn_s_barrier();
        asm volatile("" ::: "memory");
        if (n < 3) {
            if (wave < 7) { const int j = a - 5 - wave; if (j >= 0) ATT_DMA_TILE(j); }
            const bf16_t* qp = PROJ + (rowbase + (qb - 8) * 32 + r32) * NPROJ + h * HD + hi * 8;
#pragma unroll
            for (int s = 0; s < 4; ++s) qn[s] = *(const bf16x8*)(qp + 16 * s);
        }
        f32x16 o0, o1;
#pragma unroll
        for (int r = 0; r < 16; ++r) { o0[r] = 0.f; o1[r] = 0.f; }
        float run = 1.f; bool more = true; int j = qb;
        kl.bp = att_slot(lds, j);
        AttKf kf = att_read_k(kl, hi); AttVf vf = att_read_v(kl);
        f32x16 p = att_qk(kf, qf);
        kl.bp = att_slot(lds, j > 0 ? j - 1 : 0); kf = att_read_k(kl, hi);
        AttPb pbp; AttVf vfp;
        {
            const f32x16 pn = att_qk(kf, qf);
            pbp = att_weights<true>(p, r32, hi, run); vfp = vf; p = pn;
            if (wave == 7 && n < 3 && a >= 12) { asm volatile("s_waitcnt lgkmcnt(0)" ::: "memory"); ATT_DMA_TILE(a - 12); }
            if (n > 0) {
#pragma unroll
                for (int g = 0; g < 4; ++g) { *(u32x2*)(pend_op + 8 * g) = pend[2 * g]; *(u32x2*)(pend_op + 32 + 8 * g) = pend[2 * g + 1]; } }
            --j;
            if (__all(run < 1.0e-38f)) more = false;
        }
#pragma unroll 1
        for (int r = 1; r < 5 && more && j >= 0; ++r) {
            kl.bp = att_slot(lds, j); vf = att_read_v(kl);
            kl.bp = att_slot(lds, j > 0 ? j - 1 : 0); kf = att_read_k(kl, hi);
            const f32x16 pn = att_qk(kf, qf);
            att_pv(vfp, pbp, o0, o1);
            pbp = att_weights<false>(p, r32, hi, run); vfp = vf; p = pn;
            --j;
            if (__all(run < 1.0e-38f)) more = false;
        }
        att_pv(vfp, pbp, o0, o1);
#pragma unroll 1
        for (; more && j >= 0; --j) {
            AttKvGlb kg; kg.kp = PROJ + (rowbase + (size_t)j * 32 + r32) * NPROJ + SBW + h * HD + 8 * hi; kg.vp = VT + ((size_t)(b * NH + h) * (SEQ / 32) + j) * (HD * 32) + r32 * 32 + 4 * hi;
            const AttKf kg_k = att_read_k(kg, hi); const AttVf kg_v = att_read_v(kg);
            const f32x16 pg = att_qk(kg_k, qf);
            const AttPb pbg = att_weights<false>(pg, r32, hi, run);
            att_pv(kg_v, pbg, o0, o1);
            if (__all(run < 1.0e-38f)) break;
        }
        float ss = 0.f;
#pragma unroll
        for (int r = 0; r < 16; ++r) ss += o0[r] * o0[r] + o1[r] * o1[r];
        ss += __shfl_xor(ss, 32);
        const float rstd = 1.0f / sqrtf(ss * (1.0f / HD) + NORM_EPS);
        pend_op = MIX + (rowbase + qb * 32 + r32) * D + h * HD + 4 * hi;
#pragma unroll
        for (int g = 0; g < 4; ++g) {
            u32x2 w0, w1;
            w0.x = cvt_pk_bf16(o0[4 * g + 0] * rstd, o0[4 * g + 1] * rstd); w0.y = cvt_pk_bf16(o0[4 * g + 2] * rstd, o0[4 * g + 3] * rstd);
            w1.x = cvt_pk_bf16(o1[4 * g + 0] * rstd, o1[4 * g + 1] * rstd); w1.y = cvt_pk_bf16(o1[4 * g + 2] * rstd, o1[4 * g + 3] * rstd);
            pend[2 * g] = w0; pend[2 * g + 1] = w1;
        }
#pragma unroll
        for (int s = 0; s < 4; ++s) qf[s] = qn[s];
    }
#pragma unroll
    for (int g = 0; g < 4; ++g) { *(u32x2*)(pend_op + 8 * g) = pend[2 * g]; *(u32x2*)(pend_op + 32 + 8 * g) = pend[2 * g + 1]; }
#undef ATT_DMA_TILE
}

template <int g, int NT> __device__ __forceinline__ void pool_tiles_g(const bf16_t* __restrict__ PROJ, bf16_t* __restrict__ MIX, int tile0, int tile1, int lane) {
    constexpr int w = 2 << g, NR = w - 1 + 32;
    unsigned x[NT][NR];
#pragma unroll
    for (int q = 0; q < NT; ++q) { const int tok0 = (q ? tile1 : tile0) * 32; const bool head = (tok0 & (SEQ - 1)) == 0;
        const unsigned* src = (const unsigned*)(PROJ + (size_t)tok0 * NPROJ + 3 * SBW + g * 128) + lane;
#pragma unroll
        for (int i = 0; i < NR; ++i) { const int row = i - (w - 1); x[q][i] = 0u; if (row >= 0 || !head) x[q][i] = src[(long)row * (NPROJ / 2)]; } }
#pragma unroll
    for (int q = 0; q < NT; ++q) { const int tok0 = (q ? tile1 : tile0) * 32; const bool head = (tok0 & (SEQ - 1)) == 0;
        unsigned* dst = (unsigned*)(MIX + (size_t)tok0 * D + SBW + g * 128) + lane;
        float s0 = 0.f, s1 = 0.f;
#pragma unroll
        for (int i = 0; i < w - 1; ++i) { s0 += bflo(x[q][i]); s1 += bfhi(x[q][i]); }
#pragma unroll
        for (int t = 0; t < 32; ++t) { const unsigned xi = x[q][w - 1 + t]; s0 += bflo(xi); s1 += bfhi(xi);
            const float inv = (head && t + 1 < w) ? 1.0f / (float)(t + 1) : 1.0f / (float)w;
            dst[(size_t)t * (D / 2)] = cvt_pk_bf16(s0 * inv - bflo(xi), s1 * inv - bfhi(xi));
            s0 -= bflo(x[q][t]); s1 -= bfhi(x[q][t]); } }
}

template <int NT> __device__ __forceinline__ void pool_tiles(const bf16_t* __restrict__ PROJ, bf16_t* __restrict__ MIX, int task0, int task1, int lane) {
    const int g = task0 & 3, t0 = task0 >> 2, t1 = task1 >> 2;
    if (g == 0) pool_tiles_g<0, NT>(PROJ, MIX, t0, t1, lane); else if (g == 1) pool_tiles_g<1, NT>(PROJ, MIX, t0, t1, lane);
    else if (g == 2) pool_tiles_g<2, NT>(PROJ, MIX, t0, t1, lane); else pool_tiles_g<3, NT>(PROJ, MIX, t0, t1, lane);
}

__device__ __forceinline__ void build_moe_tables(LAS unsigned char* misc, const unsigned* gcnt, int tid) {
    LAS int* l_cnt = (LAS int*)(misc + MO_CNT); LAS int* l_ts = (LAS int*)(misc + MO_TSTART); LAS int* l_T = (LAS int*)(misc + MO_T); LAS int* l_te = (LAS int*)(misc + MO_TILEE);
    if (tid < 64) {
        const int e = tid & 31; const int c = (int)__hip_atomic_load(gcnt + e, RLX_AGENT); const int ntl = (c + 255) >> 8;
        int incl = ntl;
#pragma unroll
        for (int o = 1; o < 32; o <<= 1) { const int v = __shfl_up(incl, o, 32); if (e >= o) incl += v; }
        if (tid < 32) { l_cnt[e] = c; l_ts[e] = incl - ntl; if (e == 31) { l_ts[32] = incl; l_T[0] = incl; } }
    }
    __syncthreads();
    const int T = l_T[0];
    for (int rt = tid; rt < T; rt += NWAVES * 64) { int e = 0;
#pragma unroll 1
        for (int k = 1; k < 32; ++k) if (l_ts[k] <= rt) e = k;
        l_te[rt] = e; }
    __syncthreads();
}

__global__ void __launch_bounds__(NWAVES * 64, 2) mk_fwd(Args args) {
    extern __shared__ __attribute__((aligned(16))) unsigned char lds_raw[];
    LAS unsigned char* lds = (LAS unsigned char*)lds_raw;
    LAS unsigned char* misc = lds + MISC_OFF;
    const int tid = threadIdx.x, lane = tid & 63, wave = __builtin_amdgcn_readfirstlane(tid >> 6);
    const int G = gridDim.x; const int bx = blockIdx.x; const int vcu = (G % 8 == 0) ? (bx % 8) * (G / 8) + bx / 8 : bx;
    unsigned char* ws = args.ws;
    unsigned* ctl = (unsigned*)(ws + WS_CTL);
    bf16_t* Win_t = (bf16_t*)(ws + WS_WIN); bf16_t* Wout_t = (bf16_t*)(ws + WS_WOUT); float* Wr_t = (float*)(ws + WS_WR);
    bf16_t* Wgu_t = (bf16_t*)(ws + WS_WGU); bf16_t* Wd_t = (bf16_t*)(ws + WS_WD);
    float* X1 = (float*)(ws + WS_X1); bf16_t* H2 = (bf16_t*)(ws + WS_H2); int* LTOK = (int*)(ws + WS_LTOK); float* LGATE = (float*)(ws + WS_LGATE); int* TCODE = (int*)(ws + WS_TCODE); float* LRSTD = (float*)(ws + WS_LRSTD); float* RMS = (float*)(ws + WS_LGATE + 1 * MiB); float* WPE = (float*)(ws + WS_LGATE + 2 * MiB);
    bf16_t* HMID = (bf16_t*)(ws + WS_HMID); bf16_t* YB = (bf16_t*)(ws + WS_Y); bf16_t* XN = (bf16_t*)(ws + WS_XN); bf16_t* PROJ = (bf16_t*)(ws + WS_PROJ); bf16_t* MIX = (bf16_t*)(ws + WS_MIX); bf16_t* VT = (bf16_t*)(ws + WS_VT);

    for (int u = tid; u < (LDS_BYTES - MISC_OFF) / 4; u += NWAVES * 64) ((LAS unsigned*)misc)[u] = 0u;
    __syncthreads();
    XcdBarrier bar; bar.bar = ctl + CW_BAR; bar.x = 0; bar.st = nullptr;
    if (MK_N_LAUNCHES == 1) bar = xcd_barrier_post(ctl + CW_BAR, (volatile LAS unsigned*)(misc + MO_BAR));
#define GRID_BAR() do { if (MK_N_LAUNCHES == 1) xcd_barrier(bar); } while (0)
    const int lo = args.ph_lo, hi_ph = args.ph_hi;
#define IN(k) (lo <= (k) && (k) < hi_ph)
#define BOTH(k) (IN(k) && IN((k) + 1))
    const int gw = vcu * NWAVES + wave, NGW = G * NWAVES;

    if (IN(0)) { {
        LAS float* scr = (LAS float*)(lds + wave * 16384);
        constexpr int I_IN = (D / 64) * (NPROJ / 32), I_OUT = (SBW / 64) * (D / 32), I_GU = (D / 64) * (2 * FF / 32), I_DN = (FF / 64) * (D / 32);
        constexpr int NITEMS = I_IN + I_OUT + NE * I_GU + NE * I_DN;
        for (int it = gw; it < NITEMS; it += NGW) {
            int r = it;
            if (r < I_IN) { const int nb = NPROJ / 32, kb = r / nb, n0 = (r % nb) * 32; p0_transpose_item(args.w_in, NPROJ, Win_t, D, kb * 64, n0, n0, scr, lane, args.norm1_g); continue; } r -= I_IN;
            if (r < I_OUT) { const int nb = D / 32, kb = r / nb, n0 = (r % nb) * 32; p0_transpose_item(args.w_out, D, Wout_t, D, kb * 64, n0, n0, scr, lane, args.sb_norm_g); continue; } r -= I_OUT;
            if (r < NE * I_GU) { const int e = r / I_GU, q = r % I_GU, nb = 2 * FF / 32, kb = q / nb, n0 = (q % nb) * 32;
                const int j = n0 & (FF - 1), drow = (j >> 7) * 256 + (n0 >= FF ? 128 : 0) + (j & 127);
                if (MOE_FP8) p0_transpose_item_f8(args.w_gate_up + (size_t)e * D * 2 * FF, 2 * FF, (unsigned char*)Wgu_t + (size_t)e * 2 * FF * D, D, kb * 64, n0, drow, scr, lane);
                else p0_transpose_item(args.w_gate_up + (size_t)e * D * 2 * FF, 2 * FF, Wgu_t + (size_t)e * 2 * FF * D, D, kb * 64, n0, drow, scr, lane);
                continue; } r -= NE * I_GU;
            if (r < NE * I_DN) { const int e = r / I_DN, q = r % I_DN, nb = D / 32, kb = q / nb, n0 = (q % nb) * 32;
                if (MOE_FP8) p0_transpose_item_f8(args.w_down + (size_t)e * FF * D, D, (unsigned char*)Wd_t + (size_t)e * D * FF, FF, kb * 64, n0, n0, scr, lane);
                else p0_transpose_item(args.w_down + (size_t)e * FF * D, D, Wd_t + (size_t)e * D * FF, FF, kb * 64, n0, n0, scr, lane);
                continue; }
        }
        for (int i = bx * (NWAVES * 64) + tid; i < SBW * D / 4; i += G * NWAVES * 64) { const int rc = i >> 8, n = (i & 255) * 4, g = rc >> 7;
            const float* wp = args.w_pool + (size_t)rc * 128; const float* ps = args.pool_scale + g * 128; const float* wo = args.w_out + (size_t)(SBW + 128 * g) * D + n;
            f32x4 a4 = (f32x4){0.f, 0.f, 0.f, 0.f};
#pragma unroll 8
            for (int d = 0; d < 128; ++d) a4 += *(const f32x4*)(wo + (size_t)d * D) * (wp[d] * ps[d]);
            *(f32x4*)(WPE + (size_t)rc * D + n) = a4; }
        for (int i = bx * (NWAVES * 64) + tid; i < NE * D; i += G * NWAVES * 64) { const int e = i >> 10, k = i & 1023; const float w = args.w_router[k * NE + e];
            const unsigned hb = f2bf(w); const float wl = w - __builtin_bit_cast(float, hb << 16); ((bf16_t*)Wr_t)[i] = (bf16_t)hb; ((bf16_t*)Wr_t)[NE * D + i] = (bf16_t)f2bf(wl); }
        for (int m = gw; m < M; m += NGW) {
            const f32x4* xr = (const f32x4*)(args.x + (size_t)m * D) + lane;
            f32x4 v[4]; float s = 0.f;
#pragma unroll
            for (int j = 0; j < 4; ++j) { v[j] = xr[64 * j]; s += (v[j].x * v[j].x + v[j].y * v[j].y) + (v[j].z * v[j].z + v[j].w * v[j].w); }
            const float rms = sqrtf(wave_sum(s) * (1.0f / D) + NORM_EPS), rstd = 1.0f / rms;
            if (lane == 0) RMS[m] = rms;
            unsigned long long* o8 = (unsigned long long*)(XN + (size_t)m * D) + lane;
#pragma unroll
            for (int j = 0; j < 4; ++j)
                o8[64 * j] = (unsigned long long)pk2(v[j].x * rstd, v[j].y * rstd) | ((unsigned long long)pk2(v[j].z * rstd, v[j].w * rstd) << 32);
        }
}         if (BOTH(0)) GRID_BAR();
    }

    if (IN(1)) { {
        pg8::Gemm g{XN, Win_t, D}; pg8::DenseOrder S{M / 256, NPROJ / 256, G, bx};
        pg8::EpiProj E{PROJ, VT, lds + 3 * pg8::HTB};
        pg8::gemm_phase<pg8::EpiProj, pg8::DenseOrder, true>(lds, g, S, E);
}         if (BOTH(1)) GRID_BAR();
    }

    if (IN(2)) { {
        const int wr32 = lane & 31, whi = lane >> 5;
        for (int bt = vcu, first = 1; bt < BATCH * NH * (SEQ / 1024); bt += G, first = 0) {
            float wv[4] = {0.f, 0.f, 0.f, 0.f}; const int it = gw, k0 = (it >> 5) * 8 + 4 * whi, n = (it & 31) * 32 + wr32;
            const bool wj = first && it < (SBW / 8) * (D / 32);
            if (wj) {
#pragma unroll
                for (int j = 0; j < 4; ++j) wv[j] = WPE[(size_t)(k0 + j) * D + n]; }
            attn_block(PROJ, VT, MIX, lds, bt, wave, lane, [&]() { if (wj) { u32x2 o; o.x = pk2(wv[0], wv[1]); o.y = pk2(wv[2], wv[3]); *(u32x2*)(Wout_t + (size_t)n * D + SBW + k0) = o; } });
        }
        for (int it = gw + NGW; it < (SBW / 8) * (D / 32); it += NGW) { const int k0 = (it >> 5) * 8 + 4 * whi, n = (it & 31) * 32 + wr32;
            u32x2 o; o.x = pk2(WPE[(size_t)k0 * D + n], WPE[(size_t)(k0 + 1) * D + n]); o.y = pk2(WPE[(size_t)(k0 + 2) * D + n], WPE[(size_t)(k0 + 3) * D + n]); *(u32x2*)(Wout_t + (size_t)n * D + SBW + k0) = o; }
        for (int t = gw; t < (M / 32) * 4; t += 2 * NGW) { if (t + NGW < (M / 32) * 4) pool_tiles<2>(PROJ, MIX, t, t + NGW, lane); else pool_tiles<1>(PROJ, MIX, t, t, lane); }
}         if (BOTH(2)) GRID_BAR();
    }

#define P4_FILL_LDS() do { const u32x4* src_ = (const u32x4*)Wr_t; \
          for (int i_ = tid; i_ < 2 * NE * D / 8; i_ += NWAVES * 64) { const int row_ = i_ >> 7, c_ = i_ & 127; *(LAS u32x4*)(lds + row_ * 2048 + ((c_ ^ (row_ & 15)) << 4)) = src_[i_]; } \
          if (tid < D / 4) ((LAS f32x4*)(misc + 16384))[tid] = ((const f32x4*)args.norm2_g)[tid]; } while (0)
    if (IN(3)) { {
        pg8::Gemm g{MIX, Wout_t, D}; pg8::DenseOrder S{M / 256, D / 256, G, bx};
        pg8::EpiRes E{XN, RMS, (bf16_t*)X1};
        pg8::gemm_phase<pg8::EpiRes, pg8::DenseOrder, true>(lds, g, S, E);
        if (MK_N_LAUNCHES == 1 && IN(4)) P4_FILL_LDS();
}         if (BOTH(3)) GRID_BAR();
    }

    if (IN(4)) {
        LAS int* r_e = (LAS int*)(misc + MO_RT);
        LAS float* r_g = (LAS float*)(misc + MO_RT + 2048);
        LAS int* r_lr = (LAS int*)(misc + MO_RT + 4096);
        LAS int* l_cnt = (LAS int*)(misc + MO_RT + 6144);
        LAS int* l_base = (LAS int*)(misc + MO_RT + 6144 + 128);
        LAS float* r_rs = (LAS float*)(misc + MO_RT + 6144 + 256);
        if (MK_N_LAUNCHES != 1 || !IN(3)) P4_FILL_LDS();
        for (int blk = bx; blk < M / 128; blk += G) {
            if (tid < 32) l_cnt[tid] = 0;
            __syncthreads();
            {
                const int t = lane & 15, g = lane >> 4; const int rl = wave * 16 + t; const int tok = blk * 128 + rl;
                const bf16_t* xp = (const bf16_t*)X1 + (size_t)tok * D + 8 * g; const LAS float* gp = (const LAS float*)(misc + 16384) + 8 * g;
                unsigned char* hp = (unsigned char*)H2 + (size_t)tok * D + 8 * g;
                const LAS unsigned char* wrow = lds + t * 2048;
                f32x4 acc0 = (f32x4){0.f, 0.f, 0.f, 0.f}, acc1 = acc0; float ss = 0.f;
                u32x4 xq[2][4];
#define P4_LOADX(buf, grp) do { _Pragma("unroll") for (int s_ = 0; s_ < 4; ++s_) xq[buf][s_] = *(const u32x4*)(xp + 32 * (4 * (grp) + s_)); } while (0)
#define P4_GROUP(buf, grp) do { _Pragma("unroll") for (int s4 = 0; s4 < 4; ++s4) { const int sgm = 4 * (grp) + s4; \
                    const f32x4 xa = (f32x4){bflo(xq[buf][s4].x), bfhi(xq[buf][s4].x), bflo(xq[buf][s4].y), bfhi(xq[buf][s4].y)}, xb = (f32x4){bflo(xq[buf][s4].z), bfhi(xq[buf][s4].z), bflo(xq[buf][s4].w), bfhi(xq[buf][s4].w)}; \
                    const f32x4 ga = *(const LAS f32x4*)(gp + 32 * sgm), gb = *(const LAS f32x4*)(gp + 32 * sgm + 4); \
                    const int wco = ((4 * sgm + g) ^ t) << 4; \
                    const bf16x8 a_h0 = *(const LAS bf16x8*)(wrow + wco), a_h1 = *(const LAS bf16x8*)(wrow + 32768 + wco), a_l0 = *(const LAS bf16x8*)(wrow + 65536 + wco), a_l1 = *(const LAS bf16x8*)(wrow + 98304 + wco); \
                    ss += (xa.x * xa.x + xa.y * xa.y) + (xa.z * xa.z + xa.w * xa.w) + (xb.x * xb.x + xb.y * xb.y) + (xb.z * xb.z + xb.w * xb.w); \
                    const f32x4 ya = xa * ga, yb = xb * gb; \
                    u32x2 h8; h8.x = pk4_fp8(ya.x, ya.y, ya.z, ya.w); h8.y = pk4_fp8(yb.x, yb.y, yb.z, yb.w); \
                    if (MOE_FP8) *(u32x2*)(hp + 32 * sgm) = h8; \
                    u32x4 yh; yh.x = cvt_pk_bf16(ya.x, ya.y); yh.y = cvt_pk_bf16(ya.z, ya.w); yh.z = cvt_pk_bf16(yb.x, yb.y); yh.w = cvt_pk_bf16(yb.z, yb.w); \
                    if (!MOE_FP8) *(u32x4*)((bf16_t*)H2 + (size_t)tok * D + 8 * g + 32 * sgm) = yh; \
                    u32x4 yl; yl.x = cvt_pk_bf16(ya.x - bflo(yh.x), ya.y - bfhi(yh.x)); yl.y = cvt_pk_bf16(ya.z - bflo(yh.y), ya.w - bfhi(yh.y)); \
                    yl.z = cvt_pk_bf16(yb.x - bflo(yh.z), yb.y - bfhi(yh.z)); yl.w = cvt_pk_bf16(yb.z - bflo(yh.w), yb.w - bfhi(yh.w)); \
                    const bf16x8 b_h = __builtin_bit_cast(bf16x8, yh), b_l = __builtin_bit_cast(bf16x8, yl); \
                    acc0 = __builtin_amdgcn_mfma_f32_16x16x32_bf16(a_h0, b_h, acc0, 0, 0, 0); acc1 = __builtin_amdgcn_mfma_f32_16x16x32_bf16(a_h1, b_h, acc1, 0, 0, 0); \
                    acc0 = __builtin_amdgcn_mfma_f32_16x16x32_bf16(a_h0, b_l, acc0, 0, 0, 0); acc1 = __builtin_amdgcn_mfma_f32_16x16x32_bf16(a_h1, b_l, acc1, 0, 0, 0); \
                    acc0 = __builtin_amdgcn_mfma_f32_16x16x32_bf16(a_l0, b_h, acc0, 0, 0, 0); acc1 = __builtin_amdgcn_mfma_f32_16x16x32_bf16(a_l1, b_h, acc1, 0, 0, 0); \
                    asm volatile("" : "+v"(acc0), "+v"(acc1), "+v"(ss)); } } while (0)
                P4_LOADX(0, 0);
#pragma unroll 1
                for (int g2i = 0; g2i < 4; ++g2i) {
                    P4_LOADX(1, 2 * g2i + 1); asm volatile("" ::: "memory");
                    P4_GROUP(0, 2 * g2i);
                    if (g2i < 3) P4_LOADX(0, 2 * g2i + 2);
                    asm volatile("" ::: "memory");
                    P4_GROUP(1, 2 * g2i + 1);
                }
#undef P4_GROUP
#undef P4_LOADX
                ss += __shfl_xor(ss, 16); ss += __shfl_xor(ss, 32);
                const float rstd = 1.0f / sqrtf(ss * (1.0f / D) + NORM_EPS);
                unsigned key[8];
#pragma unroll
                for (int i = 0; i < 8; ++i) { const int e = (i < 4) ? 4 * g + i : 16 + 4 * g + (i - 4); const float lg = ((i < 4) ? acc0[i & 3] : acc1[i & 3]) * rstd + args.b_router[e];
                    const unsigned ub = __builtin_bit_cast(unsigned, lg); const unsigned od = ub ^ ((ub >> 31) ? 0xffffffffu : 0x80000000u); key[i] = (od & ~31u) | (unsigned)(31 - e); }
                unsigned v0 = 0u, v1 = 0u, v2 = 0u, v3 = 0u;
#define TOP_INS(x) do { unsigned x_ = (x), lo_; lo_ = min(v0, x_); v0 = max(v0, x_); x_ = lo_; lo_ = min(v1, x_); v1 = max(v1, x_); x_ = lo_; lo_ = min(v2, x_); v2 = max(v2, x_); x_ = lo_; v3 = max(v3, x_); } while (0)
#pragma unroll
                for (int i = 0; i < 8; ++i) TOP_INS(key[i]);
#pragma unroll
                for (int o = 16; o <= 32; o <<= 1) { const unsigned p0 = __shfl_xor(v0, o), p1 = __shfl_xor(v1, o), p2 = __shfl_xor(v2, o), p3 = __shfl_xor(v3, o); TOP_INS(p0); TOP_INS(p1); TOP_INS(p2); TOP_INS(p3); }
#undef TOP_INS
                float sv[4]; int se[4]; const unsigned vv[4] = {v0, v1, v2, v3};
#pragma unroll
                for (int k = 0; k < 4; ++k) { se[k] = 31 - (int)(vv[k] & 31u); const unsigned od = vv[k] & ~31u; const unsigned ub = (od & 0x80000000u) ? (od ^ 0x80000000u) : ~od; sv[k] = __builtin_bit_cast(float, ub); }
                const float e1 = __expf(sv[1] - sv[0]), e2 = __expf(sv[2] - sv[0]), e3 = __expf(sv[3] - sv[0]); const float rsum = 1.0f / (1.0f + e1 + e2 + e3);
                { const int myE = g == 0 ? se[0] : g == 1 ? se[1] : g == 2 ? se[2] : se[3]; const float myG = (g == 0 ? 1.0f : g == 1 ? e1 : g == 2 ? e2 : e3) * rsum;
                  const int lr = __hip_atomic_fetch_add(l_cnt + myE, 1, __ATOMIC_RELAXED, __HIP_MEMORY_SCOPE_WORKGROUP);
                  r_e[rl * 4 + g] = myE; r_g[rl * 4 + g] = myG; r_lr[rl * 4 + g] = lr; if (g == 0) r_rs[rl] = rstd; }
            }
            __syncthreads();
            if (tid < 32) l_base[tid] = (int)__hip_atomic_fetch_add(ctl + CW_CNT + tid, (unsigned)l_cnt[tid], RLX_AGENT);
            __syncthreads();
            { const int rl = tid >> 2, k = tid & 3; const int e = r_e[tid]; const int rank = l_base[e] + r_lr[tid]; const int tok = blk * 128 + rl;
              LTOK[(size_t)e * LISTCAP + rank] = tok; LGATE[tok * 4 + k] = r_g[tid]; LRSTD[(size_t)e * LISTCAP + rank] = r_rs[rl]; TCODE[tok * 4 + k] = rank * 32 + e; }
            __syncthreads();
        }
        if (BOTH(4)) GRID_BAR();
    }

    if (IN(5)) { {
        build_moe_tables(misc, ctl + CW_CNT, tid);
        const int T = ((LAS int*)(misc + MO_T))[0];
        pg8::Gemm g{H2, Wgu_t, D * MOE_EB / 2};
        pg8::MoeOrder<true> S{T, 2 * FF / 256, G, bx, (const LAS int*)(misc + MO_TILEE), (const LAS int*)(misc + MO_TSTART), (const LAS int*)(misc + MO_CNT), LTOK, (const LAS unsigned short*)(misc + MO_IDS)};
        pg8::EpiSwiglu E{HMID, args.b_gate_up, LRSTD, (const LAS float*)(misc + MO_RS), misc + MO_BIAS};
        { LAS unsigned short* ids = (LAS unsigned short*)(misc + MO_IDS); LAS float* rsl = (LAS float*)(misc + MO_RS); pg8::Unit u;
          unsigned val[MAXU]; const int r = tid & 255; const unsigned* src = (tid < 256) ? (const unsigned*)LTOK : (const unsigned*)LRSTD;
#pragma unroll
          for (int i = 0; i < MAXU; ++i) { val[i] = 0u; if (S.next(i, u)) { const int rk = u.rank0 + r; if (rk < u.cnt) val[i] = src[(size_t)u.e * LISTCAP + rk]; } }
#pragma unroll
          for (int i = 0; i < MAXU; ++i) { if (tid < 256) ids[i * 256 + r] = (unsigned short)val[i]; else rsl[i * 256 + r] = __builtin_bit_cast(float, val[i]); }
          __syncthreads(); }
        pg8::gemm_phase<pg8::EpiSwiglu, pg8::MoeOrder<true>, true, MOE_FP8 != 0>(lds, g, S, E);
}         if (BOTH(5)) GRID_BAR();
    }

    if (IN(6)) { {
        if (MK_N_LAUNCHES != 1 || !IN(5)) build_moe_tables(misc, ctl + CW_CNT, tid);
        const int T = ((LAS int*)(misc + MO_T))[0];
        pg8::Gemm g{HMID, Wd_t, FF * MOE_EB / 2};
        pg8::MoeOrder<false> S{T, D / 256, G, bx, (const LAS int*)(misc + MO_TILEE), (const LAS int*)(misc + MO_TSTART), (const LAS int*)(misc + MO_CNT), LTOK, (const LAS unsigned short*)(misc + MO_IDS)};
        pg8::EpiDown E{(unsigned char*)YB, args.b_down, misc + MO_BIAS};
        pg8::gemm_phase<pg8::EpiDown, pg8::MoeOrder<false>, true, MOE_FP8 != 0>(lds, g, S, E);
}         if (BOTH(6)) GRID_BAR();
    }

    if (IN(7)) { {
        if (MK_N_LAUNCHES != 1 || !IN(5)) build_moe_tables(misc, ctl + CW_CNT, tid);
        const LAS int* l_ts = (const LAS int*)(misc + MO_TSTART);
        int code[4][4], ncode[4][4]; float gt[4][4], ngt[4][4];
#define P7_CODES(C, G, m0_) do { _Pragma("unroll") for (int q = 0; q < 4; ++q) { const int m_ = (m0_) + q * NGW; const int mm_ = m_ < M ? m_ : M - 1; \
            _Pragma("unroll") for (int k = 0; k < 4; ++k) { C[q][k] = TCODE[mm_ * 4 + k]; G[q][k] = LGATE[mm_ * 4 + k] * (1.0f / pg8::Y8_SCALE); } } } while (0)
        P7_CODES(code, gt, gw);
        for (int m0 = gw; m0 < M; m0 += 4 * NGW) {
            f32x4 v[4][4]; unsigned y[4][4][4];
            P7_CODES(ncode, ngt, (m0 + 4 * NGW < M ? m0 + 4 * NGW : m0));
#pragma unroll
            for (int q = 0; q < 4; ++q) { const int m = m0 + q * NGW; const int mm = m < M ? m : M - 1; const u32x2* xr = (const u32x2*)((const bf16_t*)X1 + (size_t)mm * D) + lane;
#pragma unroll
                for (int j = 0; j < 4; ++j) { const u32x2 xb = xr[64 * j]; v[q][j] = (f32x4){bflo(xb.x), bfhi(xb.x), bflo(xb.y), bfhi(xb.y)}; } }
#pragma unroll
            for (int q = 0; q < 4; ++q)
#pragma unroll
                for (int k = 0; k < 4; ++k) { const int e = code[q][k] & 31, rank = code[q][k] >> 5; const size_t pos = (size_t)l_ts[e] * 256 + rank; const unsigned* yr = (const unsigned*)((const unsigned char*)YB + pos * D) + lane;
#pragma unroll
                    for (int j = 0; j < 4; ++j) y[q][k][j] = yr[64 * j]; }
#pragma unroll
            for (int q = 0; q < 4; ++q) { const int m = m0 + q * NGW; if (m >= M) continue;
#pragma unroll
                for (int k = 0; k < 4; ++k)
#pragma unroll
                    for (int j = 0; j < 4; ++j) { const f32x2 lo = __builtin_amdgcn_cvt_pk_f32_fp8((int)y[q][k][j], false), hi = __builtin_amdgcn_cvt_pk_f32_fp8((int)y[q][k][j], true);
                        v[q][j].x += gt[q][k] * lo.x; v[q][j].y += gt[q][k] * lo.y; v[q][j].z += gt[q][k] * hi.x; v[q][j].w += gt[q][k] * hi.y; }
                float sq = 0.f;
#pragma unroll
                for (int j = 0; j < 4; ++j) sq += (v[q][j].x * v[q][j].x + v[q][j].y * v[q][j].y) + (v[q][j].z * v[q][j].z + v[q][j].w * v[q][j].w);
                const float rstd = 1.0f / sqrtf(wave_sum(sq) * (1.0f / D) + NORM_EPS);
                const f32x4* gr = (const f32x4*)args.final_g + lane; f32x4* orow = (f32x4*)(args.out + (size_t)m * D) + lane;
#pragma unroll
                for (int j = 0; j < 4; ++j) { const f32x4 gg = gr[64 * j]; orow[64 * j] = (f32x4){v[q][j].x * rstd * gg.x, v[q][j].y * rstd * gg.y, v[q][j].z * rstd * gg.z, v[q][j].w * rstd * gg.w}; }
            }
#pragma unroll
            for (int q = 0; q < 4; ++q)
#pragma unroll
                for (int k = 0; k < 4; ++k) { code[q][k] = ncode[q][k]; gt[q][k] = ngt[q][k]; }
        }
#undef P7_CODES
    } }
#undef IN
#undef BOTH
#undef GRID_BAR
}

extern "C" void kernel_launch(void* const* d_in, const int* in_sizes, int n_in, void* d_out, int out_size, void* d_ws, size_t ws_size, hipStream_t stream) {
    static int grid = 0;
    if (grid == 0) {
        if (n_in != 15 || in_sizes[0] != M * D || out_size != M * D || ws_size < WS_END) { fprintf(stderr, "kernel_launch: unexpected shapes (n_in %d, in0 %d, out %d, ws %zu)\n", n_in, n_in > 0 ? in_sizes[0] : -1, out_size, ws_size); grid = -1; return; }
        int dev = 0, cus = 0, per_cu = 0;
        if (hipGetDevice(&dev) != hipSuccess || hipDeviceGetAttribute(&cus, hipDeviceAttributeMultiprocessorCount, dev) != hipSuccess) { grid = -1; return; }
        if (hipFuncSetAttribute((const void*)mk_fwd, hipFuncAttributeMaxDynamicSharedMemorySize, LDS_BYTES) != hipSuccess) { fprintf(stderr, "kernel_launch: hipFuncSetAttribute failed\n"); grid = -1; return; }
        if (hipOccupancyMaxActiveBlocksPerMultiprocessor(&per_cu, (const void*)mk_fwd, NWAVES * 64, LDS_BYTES) != hipSuccess || per_cu < 1) { fprintf(stderr, "kernel_launch: occupancy query reports %d\n", per_cu); per_cu = 1; }
        (void)hipGetLastError();
        grid = cus;
    }
    if (grid < 0) return;
    if (hipMemsetAsync((char*)d_ws + WS_CTL, 0, CTL_ZERO_BYTES, stream) != hipSuccess) return;
    Args a{};
    a.x = (const float*)d_in[0]; a.norm1_g = (const float*)d_in[1]; a.w_in = (const float*)d_in[2]; a.sb_norm_g = (const float*)d_in[3]; a.w_pool = (const float*)d_in[4];
    a.pool_scale = (const float*)d_in[5]; a.w_out = (const float*)d_in[6]; a.norm2_g = (const float*)d_in[7]; a.w_router = (const float*)d_in[8]; a.b_router = (const float*)d_in[9];
    a.w_gate_up = (const float*)d_in[10]; a.b_gate_up = (const float*)d_in[11]; a.w_down = (const float*)d_in[12]; a.b_down = (const float*)d_in[13]; a.final_g = (const float*)d_in[14];
    a.out = (float*)d_out; a.ws = (unsigned char*)d_ws;
    if (MK_N_LAUNCHES == 1) { a.ph_lo = 0; a.ph_hi = PER_PHASE; hipLaunchKernelGGL(mk_fwd, dim3(grid), dim3(NWAVES * 64), LDS_BYTES, stream, a); }
    else for (int p = 0; p < PER_PHASE; ++p) { a.ph_lo = p; a.ph_hi = p + 1; hipLaunchKernelGGL(mk_fwd, dim3(grid), dim3(NWAVES * 64), LDS_BYTES, stream, a); }
}
```

```cpp
#include <hip/hip_runtime.h>
#include <cstdio>
#include <cstdint>

#define LAS __attribute__((address_space(3)))
#define GAS __attribute__((address_space(1)))

#ifndef MK_N_LAUNCHES
#define MK_N_LAUNCHES 1
#endif
#ifndef MOE_FP8
#define MOE_FP8 1
#endif

constexpr int BATCH = 4, SEQ = 8192, M = BATCH * SEQ, D = 1024, NPROJ = 2048, NE = 32, FF = 1024, TOPK = 4;
constexpr int NH = 8, HD = 64, SBW = 512;
constexpr int LISTCAP = M;
constexpr int MAXROWT = (M * TOPK) / 256 + NE;
constexpr float NORM_EPS = 1e-5f;
constexpr int NWAVES = 8;
constexpr int DEFER_E = (MK_N_LAUNCHES == 1) ? 16 : 0;
constexpr int PER_PHASE = 8;

typedef unsigned short bf16_t;
typedef short bf16x8 __attribute__((ext_vector_type(8)));
typedef float f32x4 __attribute__((ext_vector_type(4)));
typedef float f32x16 __attribute__((ext_vector_type(16)));
typedef unsigned u32x4 __attribute__((ext_vector_type(4)));
typedef unsigned u32x2 __attribute__((ext_vector_type(2)));
typedef float f32x2 __attribute__((ext_vector_type(2)));
typedef int i32x4 __attribute__((ext_vector_type(4)));
typedef int i32x8 __attribute__((ext_vector_type(8)));
constexpr int MOE_EB = MOE_FP8 ? 1 : 2;
constexpr float W8_SCALE = 64.0f;

constexpr size_t MiB = 1u << 20;
constexpr size_t WS_CTL = 0, CTL_ZERO_BYTES = 32768;
constexpr size_t WS_WIN = 1 * MiB;
constexpr size_t WS_WOUT = 5 * MiB;
constexpr size_t WS_WPOOL = 7 * MiB;
constexpr size_t WS_WR = 7 * MiB + 512 * 1024;
constexpr size_t WS_WGU = 8 * MiB;
constexpr size_t WS_WD = 136 * MiB;
constexpr size_t WS_X1 = 200 * MiB;
constexpr size_t WS_H2 = 328 * MiB;
constexpr size_t WS_LTOK = 392 * MiB;
constexpr size_t WS_LGATE = 396 * MiB;
constexpr size_t WS_TCODE = 400 * MiB;
constexpr size_t WS_LRSTD = 946 * MiB;
constexpr size_t WS_HMID = 402 * MiB;
constexpr size_t WS_Y = 674 * MiB;
constexpr size_t WS_XN = 402 * MiB;
constexpr size_t WS_PROJ = 466 * MiB;
constexpr size_t WS_MIX = 594 * MiB;
constexpr size_t WS_VT = 674 * MiB;
constexpr size_t WS_END = 950 * MiB;
static_assert(WS_MIX + (size_t)M * D * 2 <= WS_HMID + (size_t)MAXROWT * 256 * 1024 * 2, "overlay inside HMID/Y");
static_assert(WS_HMID + (size_t)MAXROWT * 256 * FF * 2 <= WS_Y && WS_Y + (size_t)MAXROWT * 256 * D * 2 <= WS_END, "ws map");

constexpr int CW_TMO = 0;
constexpr int CW_CNT = 64;
constexpr int CW_BAR = 4096;

constexpr int RING_BYTES = 131072;
constexpr int MISC_OFF = RING_BYTES;
constexpr int LDS_BYTES = 163840;
constexpr int MO_BAR = 0, MO_CNT = 64, MO_TSTART = 192, MO_T = 328, MO_TILEE = 512, MO_RT = 4096;
constexpr int MO_UT = 3328;
constexpr int PF_JUNK = RING_BYTES + 4096;
constexpr int MAXU = 17;
constexpr int MO_BIAS = 30464;
constexpr int MO_IDS = 4096, MO_RS = MO_IDS + MAXU * 256 * 2, MO_TS = MO_RS + MAXU * 256 * 4;
static_assert(MO_TS + 128 <= MO_BIAS && MO_BIAS + 2048 <= LDS_BYTES - RING_BYTES, "LDS misc map");

#define RLX_AGENT __ATOMIC_RELAXED, __HIP_MEMORY_SCOPE_AGENT
__device__ __forceinline__ unsigned f2bf(float f) { unsigned u = __builtin_bit_cast(unsigned, f); return (u + 0x7fffu + ((u >> 16) & 1u)) >> 16; }
__device__ __forceinline__ unsigned pk2(float lo, float hi) { return f2bf(lo) | (f2bf(hi) << 16); }
__device__ __forceinline__ float bf2f(unsigned short b) { return __builtin_bit_cast(float, (unsigned)b << 16); }
__device__ __forceinline__ float bflo(unsigned w) { return __builtin_bit_cast(float, w << 16); }
__device__ __forceinline__ float bfhi(unsigned w) { return __builtin_bit_cast(float, w & 0xffff0000u); }
__device__ __forceinline__ unsigned cvt_pk_bf16(float lo, float hi) { unsigned r; asm volatile("v_cvt_pk_bf16_f32 %0, %1, %2" : "=v"(r) : "v"(lo), "v"(hi)); return r; }
__device__ __forceinline__ unsigned pk4_fp8(float a, float b, float c, float d) { int w = __builtin_amdgcn_cvt_pk_fp8_f32(a, b, 0, false); w = __builtin_amdgcn_cvt_pk_fp8_f32(c, d, w, true); return (unsigned)w; }
__device__ __forceinline__ float wave_sum(float v) {
#pragma unroll
    for (int o = 1; o < 64; o <<= 1) v += __shfl_xor(v, o);
    return v;
}
__device__ __forceinline__ float wave_max(float v) {
#pragma unroll
    for (int o = 1; o < 64; o <<= 1) v = fmaxf(v, __shfl_xor(v, o));
    return v;
}
__device__ __forceinline__ float vmax0(float a) { return __builtin_amdgcn_fmed3f(a, 0.0f, __builtin_inff()); }
__device__ __forceinline__ float xhalf(float v, int hi) { const unsigned u = __builtin_bit_cast(unsigned, v); const auto r = __builtin_amdgcn_permlane32_swap(u, u, false, false);
    return __builtin_bit_cast(float, hi ? r[0] : r[1]); }
__device__ __forceinline__ int crow(int r, int hi) { return (r & 3) + 8 * (r >> 2) + 4 * hi; }

namespace pg8 {
constexpr int BM = 256, BK = 64, HALF = 128, HTB = HALF * BK * 2, STAGE_BYTES = 8 * HTB, NXCD = 8, WGM = 8;
__host__ __device__ __forceinline__ int lds_byte(int r, int c) { const int st = (r >> 4) * 2 + (c >> 5), rr = r & 15, cc = c & 31, ob = rr * 64 + cc * 2; return st * 1024 + (ob ^ (((ob >> 9) & 1) << 5)); }
__host__ __device__ __forceinline__ void stage_rc(int b, int& R, int& C) { const int st = b / 1024, sb = b % 1024, swz = sb ^ (((sb >> 9) & 1) << 5); R = (st >> 1) * 16 + swz / 64; C = (st & 1) * 32 + (swz % 64) / 2; }
__host__ __device__ __forceinline__ int perm32(int rho) { const int n = rho >> 4, i = rho & 15; return 8 * (i >> 2) + 4 * n + (i & 3); }

__host__ __device__ __forceinline__ int perm32s(int rho) { const int n = rho >> 4, i = rho & 15, fq = i >> 2; return 8 * (2 * (fq & 1) + (fq >> 1)) + 4 * n + (i & 3); }
struct Unit { int pm, pn, pnl, e, rank0, cnt, slot; };
struct Gemm { const bf16_t* A; const bf16_t* Bt; int K; };

__device__ __forceinline__ bool tile_order(long L, int nM, int nN, int& pm, int& pn) {
    const int nwg = nM * nN; if (L >= nwg) return false;
    int wgid = (int)L; { const int q = nwg / NXCD, r = nwg % NXCD, xcd = wgid % NXCD, off = wgid / NXCD; wgid = (xcd < r ? xcd * (q + 1) : r * (q + 1) + (xcd - r) * q) + off; }
    const int nig = WGM * nN, gid = wgid / nig, fm = gid * WGM, gsz = (nM - fm) < WGM ? (nM - fm) : WGM;
    pm = fm + ((wgid % nig) % gsz); pn = (wgid % nig) / gsz; return true;
}
struct DenseOrder {
    int nM, nN, G, c;
    __device__ __forceinline__ bool next(int i, Unit& u) const { int pm, pn; if (!tile_order((long)i * G + c, nM, nN, pm, pn)) return false; u.pm = pm; u.pn = pn; u.pnl = pn; u.e = 0; u.rank0 = 0; u.cnt = 0; u.slot = i; return true; }
    __device__ __forceinline__ unsigned arow(const Unit& u, int r) const { return (unsigned)(u.pm * BM + r); }
};
template <bool GATHER> struct MoeOrder {
    int T, nN, G, c; const LAS int* tile_e; const LAS int* tstart; const LAS int* cnt; const int* list_tok; const LAS unsigned short* ids;
    const LAS int* utab;
    __device__ __forceinline__ bool compute(int i, Unit& u) const {
        int pm, pn; if (!tile_order((long)i * G + c, T, nN, pm, pn)) return false;
        const int e = tile_e[pm]; u.pm = pm; u.pnl = pn; u.e = e; u.pn = e * nN + pn; u.rank0 = (pm - tstart[e]) * BM; u.cnt = cnt[e]; u.slot = i; return true;
    }
    __device__ __forceinline__ void post(LAS int* tab, int tid) const {
        if (tid <= MAXU) { int pm = 0, pn = 0; const bool ok = tile_order((long)tid * G + c, T, nN, pm, pn); const int e = ok ? tile_e[pm] : 0;
            tab[tid * 8 + 0] = pm; tab[tid * 8 + 1] = pn; tab[tid * 8 + 2] = e; tab[tid * 8 + 3] = ok ? (pm - tstart[e]) * BM : 0; tab[tid * 8 + 4] = ok ? cnt[e] : 0; tab[tid * 8 + 5] = ok ? 1 : 0; }
    }
    __device__ __forceinline__ bool next(int i, Unit& u) const {
        int pm = 0, pnl = 0, e = 0, rank0 = 0, cn = 0; bool ok;
        if (i <= MAXU) { const LAS int* t = utab + i * 8;
            ok = __builtin_amdgcn_readfirstlane(t[5]) != 0; pm = __builtin_amdgcn_readfirstlane(t[0]); pnl = __builtin_amdgcn_readfirstlane(t[1]); e = __builtin_amdgcn_readfirstlane(t[2]);
            rank0 = __builtin_amdgcn_readfirstlane(t[3]); cn = __builtin_amdgcn_readfirstlane(t[4]); }
        else { int pn = 0; ok = tile_order((long)i * G + c, T, nN, pm, pn); if (!ok) { pm = 0; pn = 0; } pnl = pn; e = tile_e[pm]; rank0 = (pm - tstart[e]) * BM; cn = cnt[e]; }
        u.pm = pm; u.pnl = pnl; u.e = e; u.pn = e * nN + pnl; u.rank0 = rank0; u.cnt = cn; u.slot = i; return ok;
    }
    __device__ __forceinline__ unsigned arow(const Unit& u, int r) const {
        if (GATHER) { if (u.slot < MAXU) return (unsigned)ids[u.slot * 256 + r];
            const int rk = u.rank0 + r; return (rk < u.cnt) ? (unsigned)list_tok[(size_t)u.e * LISTCAP + rk] : 0u; }
        return (unsigned)(u.pm * BM + r);
    }
};

struct EpiProj {
    __device__ __forceinline__ void prefetch(const Unit&, int, int, int) const {}
    static __device__ __forceinline__ int brow(int h, int R) { return h * HALF + (R & ~31) + perm32(R & 31); }
    static constexpr bool PF_A = false; static constexpr bool PERM = true;
    bf16_t* O; bf16_t* VT; LAS unsigned char* stage;
    __device__ __forceinline__ void operator()(const f32x4 (&acc)[2][2][4][2], const Unit& u, int wr, int wc, int fr, int fq) const {
        if (u.pn == 4 || u.pn == 5) {
            const int rowt = u.pm * BM; const int b = rowt / SEQ, post = (rowt % SEQ) >> 5;
            LAS unsigned char* wb = stage + (wr * 4 + wc) * 1024; const int lane = fr + 16 * fq;
#pragma unroll
            for (int ai = 0; ai < 2; ++ai)
#pragma unroll
                for (int mp = 0; mp < 2; ++mp)
#pragma unroll
                    for (int bj = 0; bj < 2; ++bj) {
#pragma unroll
                        for (int mm = 0; mm < 2; ++mm) { const int m = 2 * mp + mm; const f32x4 v0 = acc[ai][bj][m][0], v1 = acc[ai][bj][m][1];
                            const unsigned w0 = cvt_pk_bf16(v0[0], v0[1]), w1 = cvt_pk_bf16(v0[2], v0[3]), w2 = cvt_pk_bf16(v1[0], v1[1]), w3 = cvt_pk_bf16(v1[2], v1[3]);
                            LAS bf16_t* wp = (LAS bf16_t*)(wb + (fq >> 1) * 8192 + (8 * (fq & 1)) * 64 + (16 * mm + fr) * 2);
                            wp[0 * 32] = (bf16_t)w0; wp[1 * 32] = (bf16_t)(w0 >> 16); wp[2 * 32] = (bf16_t)w1; wp[3 * 32] = (bf16_t)(w1 >> 16);
                            wp[4 * 32] = (bf16_t)w2; wp[5 * 32] = (bf16_t)(w2 >> 16); wp[6 * 32] = (bf16_t)w3; wp[7 * 32] = (bf16_t)(w3 >> 16); }
                        asm volatile("" ::: "memory");
                        const int pos32 = post + 4 * ai + 2 * wr + mp; const int h = (u.pn - 4) * 4 + 2 * bj + (wc >> 1);
                        bf16_t* gp = VT + ((size_t)((b * NH + h) * (SEQ / 32) + pos32) * HD + 32 * (wc & 1)) * 32;
#pragma unroll
                        for (int i = 0; i < 2; ++i) { const int dl = (lane >> 2) + 16 * i, c = lane & 3; const u32x4 t = *(const LAS u32x4*)(wb + i * 8192 + (lane >> 2) * 64 + c * 16); *(u32x4*)(gp + dl * 32 + c * 8) = t; }
                        asm volatile("" ::: "memory");
                    }
            return;
        }
        const int row0 = u.pm * BM + wr * 64 + fr; const int col0 = u.pn * BM + wc * 32 + 8 * fq;
        if (u.pn < 2) {
            const float sc = 0.125f * 1.4426950408889634f;
#pragma unroll
            for (int ai = 0; ai < 2; ++ai)
#pragma unroll
                for (int m = 0; m < 4; ++m) { bf16_t* rowp = O + (size_t)(row0 + ai * HALF + m * 16) * NPROJ + col0;
#pragma unroll
                    for (int bj = 0; bj < 2; ++bj) { const f32x4 v0 = acc[ai][bj][m][0] * sc, v1 = acc[ai][bj][m][1] * sc;
                        u32x4 w; w.x = cvt_pk_bf16(v0[0], v0[1]); w.y = cvt_pk_bf16(v0[2], v0[3]); w.z = cvt_pk_bf16(v1[0], v1[1]); w.w = cvt_pk_bf16(v1[2], v1[3]);
                        *(u32x4*)(rowp + bj * HALF) = w; } }
        } else {
#pragma unroll
            for (int ai = 0; ai < 2; ++ai)
#pragma unroll
                for (int m = 0; m < 4; ++m) { bf16_t* rowp = O + (size_t)(row0 + ai * HALF + m * 16) * NPROJ + col0;
#pragma unroll
                    for (int bj = 0; bj < 2; ++bj) { const f32x4 v0 = acc[ai][bj][m][0], v1 = acc[ai][bj][m][1];
                        u32x4 w; w.x = cvt_pk_bf16(v0[0], v0[1]); w.y = cvt_pk_bf16(v0[2], v0[3]); w.z = cvt_pk_bf16(v1[0], v1[1]); w.w = cvt_pk_bf16(v1[2], v1[3]);
                        *(u32x4*)(rowp + bj * HALF) = w; } }
        }
    }
};
struct EpiRes {
    __device__ __forceinline__ void prefetch(const Unit&, int, int, int) const {}
    static constexpr bool PF_A = false; static constexpr bool PERM = true;
    static __device__ __forceinline__ int brow(int h, int R) { return h * HALF + (R & ~31) + perm32(R & 31); }
    const bf16_t* xn; const float* rms; bf16_t* out;
    __device__ __forceinline__ void operator()(const f32x4 (&acc)[2][2][4][2], const Unit& u, int wr, int wc, int fr, int fq) const {
        const int row0 = u.pm * BM + wr * 64 + fr, col0 = u.pn * BM + wc * 32 + 8 * fq;
        u32x4 xr[2][4][2]; float rrv[2][4];
#pragma unroll
        for (int ai = 0; ai < 2; ++ai)
#pragma unroll
            for (int m = 0; m < 4; ++m) { const size_t off = (size_t)(row0 + ai * HALF + m * 16) * D + col0; rrv[ai][m] = rms[row0 + ai * HALF + m * 16];
                xr[ai][m][0] = *(const u32x4*)(xn + off); xr[ai][m][1] = *(const u32x4*)(xn + off + HALF); }
        asm volatile("" ::: "memory");
#pragma unroll
        for (int ai = 0; ai < 2; ++ai)
#pragma unroll
            for (int m = 0; m < 4; ++m) { const size_t off = (size_t)(row0 + ai * HALF + m * 16) * D + col0; const float rr = rrv[ai][m];
#pragma unroll
                for (int bj = 0; bj < 2; ++bj) { const u32x4 xb = xr[ai][m][bj];
                    const f32x4 b0 = (f32x4){bflo(xb.x), bfhi(xb.x), bflo(xb.y), bfhi(xb.y)} * rr, b1 = (f32x4){bflo(xb.z), bfhi(xb.z), bflo(xb.w), bfhi(xb.w)} * rr;
                    const f32x4 v0 = b0 + acc[ai][bj][m][0], v1 = b1 + acc[ai][bj][m][1];
                    u32x4 w; w.x = cvt_pk_bf16(v0[0], v0[1]); w.y = cvt_pk_bf16(v0[2], v0[3]); w.z = cvt_pk_bf16(v1[0], v1[1]); w.w = cvt_pk_bf16(v1[2], v1[3]);
                    *(u32x4*)(out + off + bj * HALF) = w; } }
    }
};
struct EpiSwiglu {
    static __device__ __forceinline__ int brow(int h, int R) { return h * HALF + (R & ~31) + (MOE_FP8 ? perm32s(R & 31) : perm32(R & 31)); }
    static constexpr bool PF_A = false; static constexpr bool PERM = true;
    bf16_t* Hm; const float* bgu; const float* list_rstd; const LAS float* rsl; LAS unsigned char* bring;
    __device__ __forceinline__ void prefetch(const Unit& u, int ui, int wid, int lane) const {
        if (wid == 0) { const float* src = bgu + (size_t)u.e * (2 * FF) + u.pnl * HALF + (lane >= 32 ? FF - 128 : 0) + 4 * lane;
            __builtin_amdgcn_global_load_lds((const unsigned*)src, (LAS unsigned*)(bring + (ui & 1) * 1024), 16, 0, 0); }
    }
    __device__ __forceinline__ void operator()(const f32x4 (&acc)[2][2][4][2], const Unit& u, int wr, int wc, int fr, int fq) const {
        typedef float f32x2 __attribute__((ext_vector_type(2)));
        const int cgq = MOE_FP8 ? 2 * (fq & 1) + (fq >> 1) : fq;
        const int row0 = u.pm * BM + wr * 64 + fr; const int hc0 = u.pnl * HALF + wc * 32 + 8 * cgq;
        const LAS float* bg = (const LAS float*)(bring + (u.slot & 1) * 1024) + wc * 32 + 8 * cgq; const LAS float* bu = bg + 128;
        const f32x4 bg0 = *(const LAS f32x4*)bg, bg1 = *(const LAS f32x4*)(bg + 4); f32x4 bu0 = *(const LAS f32x4*)bu, bu1 = *(const LAS f32x4*)(bu + 4);
        bu0 += 1.0f; bu1 += 1.0f;
        float rsv[8]; u32x2 wp[2];
        if (u.slot < MAXU) {
#pragma unroll
            for (int q = 0; q < 8; ++q) rsv[q] = rsl[u.slot * 256 + wr * 64 + fr + (q >> 2) * HALF + (q & 3) * 16];
        } else {
#pragma unroll
            for (int q = 0; q < 8; ++q) { const int rk = u.rank0 + wr * 64 + fr + (q >> 2) * HALF + (q & 3) * 16; rsv[q] = (rk < u.cnt) ? list_rstd[(size_t)u.e * LISTCAP + rk] : 0.0f; }
        }
#pragma unroll
        for (int ai = 0; ai < 2; ++ai)
#pragma unroll
            for (int m = 0; m < 4; ++m) { bf16_t* rowp = Hm + (size_t)(row0 + ai * HALF + m * 16) * FF + hc0; float h[8];
                const float rs = rsv[ai * 4 + m]; const f32x2 rs2 = (f32x2){rs, rs};
#pragma unroll
                for (int n = 0; n < 2; ++n) { const f32x4 av = acc[ai][0][m][n], uv4 = acc[ai][1][m][n], bgn = n ? bg1 : bg0, bun = n ? bu1 : bu0;
#pragma unroll
                    for (int i = 0; i < 4; i += 2) {
                        f32x2 g = (f32x2){av[i], av[i + 1]} * rs2 + (f32x2){bgn[i], bgn[i + 1]}, up = (f32x2){uv4[i], uv4[i + 1]} * rs2 + (f32x2){bun[i], bun[i + 1]};
                        g.x = fminf(g.x, 7.0f); g.y = fminf(g.y, 7.0f);
                        up.x = __builtin_amdgcn_fmed3f(up.x, -6.0f, 8.0f); up.y = __builtin_amdgcn_fmed3f(up.y, -6.0f, 8.0f);
                        const f32x2 t = g * (f32x2){-1.702f * 1.4426950408889634f, -1.702f * 1.4426950408889634f};
                        f32x2 d = (f32x2){__builtin_amdgcn_exp2f(t.x), __builtin_amdgcn_exp2f(t.y)} + (f32x2){1.0f, 1.0f};
                        d.x = __builtin_amdgcn_rcpf(d.x); d.y = __builtin_amdgcn_rcpf(d.y);
                        const f32x2 hv = (g * up) * d;
                        h[n * 4 + i] = hv.x; h[n * 4 + i + 1] = hv.y; } }
                if (MOE_FP8) { u32x2 w; w.x = pk4_fp8(h[0], h[1], h[2], h[3]); w.y = pk4_fp8(h[4], h[5], h[6], h[7]);
                    if (m & 1) { const auto r0 = __builtin_amdgcn_permlane32_swap(wp[ai].x, w.x, false, false), r1 = __builtin_amdgcn_permlane32_swap(wp[ai].y, w.y, false, false);
                        u32x4 o; o.x = r0[0]; o.y = r1[0]; o.z = r0[1]; o.w = r1[1];
                        *(u32x4*)((unsigned char*)Hm + (size_t)(row0 + ai * HALF + (m - 1 + (fq >> 1)) * 16) * FF + u.pnl * HALF + wc * 32 + 16 * (fq & 1)) = o; }
                    else wp[ai] = w; }
                else { u32x4 w; w.x = cvt_pk_bf16(h[0], h[1]); w.y = cvt_pk_bf16(h[2], h[3]); w.z = cvt_pk_bf16(h[4], h[5]); w.w = cvt_pk_bf16(h[6], h[7]);
                *(u32x4*)rowp = w; } }
    }
};
constexpr float Y8_SCALE = 8.0f;
struct EpiDown {
    static constexpr bool PF_A = true; static constexpr bool PERM = true;
    static __device__ __forceinline__ int brow(int h, int R) { return 64 * (R >> 5) + 16 * ((R >> 2) & 3) + 8 * h + 4 * ((R >> 4) & 1) + (R & 3); }
    unsigned char* Y; const float* bd; LAS unsigned char* bring;
    __device__ __forceinline__ void prefetch(const Unit& u, int ui, int wid, int lane) const {
        if (wid == 0) __builtin_amdgcn_global_load_lds((const unsigned*)(bd + (size_t)u.e * D + u.pnl * BM + 4 * lane), (LAS unsigned*)(bring + (ui & 1) * 1024), 16, 0, 0);
    }
    __device__ __forceinline__ void operator()(const f32x4 (&acc)[2][2][4][2], const Unit& u, int wr, int wc, int fr, int fq) const {
        const int rt0 = wr * 64 + fr; const int col0 = u.pnl * BM + wc * 64 + 16 * fq;
        const LAS float* bp = (const LAS float*)(bring + (u.slot & 1) * 1024) + wc * 64 + 16 * fq;
        const f32x4 bv0 = *(const LAS f32x4*)bp * Y8_SCALE, bv1 = *(const LAS f32x4*)(bp + 4) * Y8_SCALE, bv2 = *(const LAS f32x4*)(bp + 8) * Y8_SCALE, bv3 = *(const LAS f32x4*)(bp + 12) * Y8_SCALE;
#pragma unroll
        for (int ai = 0; ai < 2; ++ai)
#pragma unroll
            for (int m = 0; m < 4; ++m) { const int rl = rt0 + ai * HALF + m * 16;
                const f32x4 v0 = acc[ai][0][m][0] * Y8_SCALE + bv0, v1 = acc[ai][0][m][1] * Y8_SCALE + bv1, v2 = acc[ai][1][m][0] * Y8_SCALE + bv2, v3 = acc[ai][1][m][1] * Y8_SCALE + bv3;
                u32x4 w; w.x = pk4_fp8(v0[0], v0[1], v0[2], v0[3]); w.y = pk4_fp8(v1[0], v1[1], v1[2], v1[3]); w.z = pk4_fp8(v2[0], v2[1], v2[2], v2[3]); w.w = pk4_fp8(v3[0], v3[1], v3[2], v3[3]);
                *(u32x4*)(Y + (size_t)(u.pm * BM + rl) * D + col0) = w; }
    }
};

__device__ __forceinline__ void mfma8(f32x4& c, const i32x8 a, const i32x8 b, const unsigned sa, const unsigned sb) {
    asm volatile("v_mfma_scale_f32_16x16x128_f8f6f4 %0, %1, %2, %0, %3, %4 op_sel_hi:[0,0,0]" : "+v"(c) : "v"(a), "v"(b), "v"(sa), "v"(sb));
}
__device__ __forceinline__ i32x8 cat8(bf16x8 lo, bf16x8 hi) { const i32x4 a = __builtin_bit_cast(i32x4, lo), b = __builtin_bit_cast(i32x4, hi); return __builtin_shufflevector(a, b, 0, 1, 2, 3, 4, 5, 6, 7); }
template <class Epi, class Sched, bool ALIGN_EPI, bool F8 = false>
__device__ __forceinline__ void gemm_phase(LAS unsigned char* lds, const Gemm g, const Sched& S, const Epi& E) {
    const int tid = threadIdx.x, wid = __builtin_amdgcn_readfirstlane(tid >> 6), lane = tid & 63, wr = wid >> 2, wc = wid & 3, fr = lane & 15, fq = lane >> 4;
    const int K = g.K, nt = K / BK;
    int Rst[2]; unsigned cst[2], voffB[2][2];
#pragma unroll
    for (int i = 0; i < 2; ++i) { int R, C; stage_rc(tid * 16 + i * 8192, R, C);
        Rst[i] = R; cst[i] = (unsigned)C * 2u;
#pragma unroll
        for (int h = 0; h < 2; ++h) voffB[h][i] = (unsigned)(Epi::brow(h, R) * K + C) * 2u; }
    const unsigned rowb = (unsigned)K * 2u;
    constexpr unsigned KSTEP = (unsigned)(BK * 2);
    const unsigned hstep = (unsigned)HALF * (unsigned)K * 2u;
    const unsigned tstep = 2u * hstep;
    const __amdgpu_buffer_rsrc_t rsA = __builtin_amdgcn_make_buffer_rsrc((void*)g.A, 0, 0x7fffffff, 0x00020000);
    const __amdgpu_buffer_rsrc_t rsB = __builtin_amdgcn_make_buffer_rsrc((void*)g.Bt, 0, 0x7fffffff, 0x00020000);
    const unsigned ldsw = (unsigned)wid * 1024u;
    const int aoff = lds_byte(wr * 64 + fr, fq * 8), boff = lds_byte(wc * 32 + fr, fq * 8);
#define PG8_SA(b, h) (((b) * 2 + (h)) * HTB)
#define PG8_SB(b, h) ((4 + (b) * 2 + (h)) * HTB)
#define PG8_STAGE_A(bufoff, soff, voff) do { _Pragma("unroll") for (int _i = 0; _i < 2; ++_i) \
        __builtin_amdgcn_raw_ptr_buffer_load_lds(rsA, (LAS unsigned*)(lds + (bufoff) + ldsw + _i * 8192), 16, (voff)[_i], (soff), 0, 0); } while (0)
#define PG8_STAGE_B(bufoff, soff, h) do { _Pragma("unroll") for (int _i = 0; _i < 2; ++_i) \
        __builtin_amdgcn_raw_ptr_buffer_load_lds(rsB, (LAS unsigned*)(lds + (bufoff) + ldsw + _i * 8192), 16, voffB[h][_i], (soff), 0, 0); } while (0)
#define PG8_LDA(dst, b, h) do { _Pragma("unroll") for (int m = 0; m < 4; ++m) _Pragma("unroll") for (int k = 0; k < 2; ++k) dst[m][k] = *(const LAS bf16x8*)(lds + PG8_SA(b, h) + aoff + m * 2048 + k * 1024); } while (0)
#define PG8_LDB(dst, b, h) do { _Pragma("unroll") for (int n = 0; n < 2; ++n) _Pragma("unroll") for (int k = 0; k < 2; ++k) dst[n][k] = *(const LAS bf16x8*)(lds + PG8_SB(b, h) + boff + n * 2048 + k * 1024); } while (0)
#define PG8_MMA(ai, bj, At, Bt) do { __builtin_amdgcn_s_setprio(1); if constexpr (F8) { _Pragma("unroll") for (int m = 0; m < 4; ++m) _Pragma("unroll") for (int n = 0; n < 2; ++n) \
        mfma8(acc[ai][bj][m][n], cat8(Bt[n][0], Bt[n][1]), cat8(At[m][0], At[m][1]), sc_w, sc_a); } \
        else { _Pragma("unroll") for (int m = 0; m < 4; ++m) _Pragma("unroll") for (int n = 0; n < 2; ++n) _Pragma("unroll") for (int k = 0; k < 2; ++k) \
        acc[ai][bj][m][n] = __builtin_amdgcn_mfma_f32_16x16x32_bf16(Bt[n][k], At[m][k], acc[ai][bj][m][n], 0, 0, 0); } __builtin_amdgcn_s_setprio(0); } while (0)
#define PG8_WAIT_V(n) asm volatile("s_waitcnt vmcnt(" #n ")" ::: "memory")
#define PG8_WAIT_L(n) asm volatile("s_waitcnt lgkmcnt(" #n ")" ::: "memory")
#define PG8_BAR __builtin_amdgcn_s_barrier()
#define PG8_SCHED __builtin_amdgcn_sched_barrier(0)
#define PG8_OFFS(o, u) do { _Pragma("unroll") for (int _h = 0; _h < 2; ++_h) _Pragma("unroll") for (int _i = 0; _i < 2; ++_i) o[_h][_i] = S.arow(u, _h * HALF + Rst[_i]) * rowb + cst[_i]; } while (0)
    Unit cur, nxt; int ui = 0;
    if (!S.next(0, cur)) return;
    f32x4 acc[2][2][4][2];
#pragma unroll
    for (int a = 0; a < 2; ++a)
#pragma unroll
        for (int b = 0; b < 2; ++b)
#pragma unroll
            for (int m = 0; m < 4; ++m)
#pragma unroll
                for (int n = 0; n < 2; ++n) acc[a][b][m][n] = (f32x4){0.f, 0.f, 0.f, 0.f};
    bf16x8 At[4][2], B0[2][2], B1[2][2];
    const unsigned sc_w = 0x79797979u, sc_a = 0x7f7f7f7fu;
    unsigned oc[2][2], on[2][2];
    PG8_OFFS(oc, cur);
    unsigned cB = (unsigned)__builtin_amdgcn_readfirstlane((int)((unsigned)cur.pn * tstep));
    PG8_STAGE_B(PG8_SB(0, 0), cB, 0); PG8_STAGE_B(PG8_SB(0, 1), cB, 1); PG8_STAGE_A(PG8_SA(0, 0), 0u, oc[0]); PG8_STAGE_A(PG8_SA(0, 1), 0u, oc[1]);
    if (wr == 1) PG8_BAR;
    PG8_WAIT_V(2); PG8_BAR;
    PG8_STAGE_B(PG8_SB(1, 0), cB + KSTEP, 0); PG8_STAGE_A(PG8_SA(1, 0), KSTEP, oc[0]); PG8_STAGE_B(PG8_SB(1, 1), cB + KSTEP, 1);
    PG8_WAIT_V(6); PG8_BAR;
    for (;;) {
        E.prefetch(cur, ui, wid, lane);
        const bool has_next = S.next(ui + 1, nxt);
        const unsigned nB = (unsigned)__builtin_amdgcn_readfirstlane((int)(has_next ? (unsigned)nxt.pn * tstep : cB));
        if (has_next) { PG8_OFFS(on, nxt); } else {
#pragma unroll
            for (int h = 0; h < 2; ++h)
#pragma unroll
                for (int i = 0; i < 2; ++i) on[h][i] = oc[h][i]; }
#pragma unroll 1
        for (int t = 0; t < nt; t += 2) {
            const bool last = (t == nt - 2);
            const unsigned a1 = (unsigned)(t + 1) * KSTEP;
            const unsigned a2 = last ? 0u : (unsigned)(t + 2) * KSTEP; const unsigned b2 = last ? nB : cB + (unsigned)(t + 2) * KSTEP;
            const unsigned a3 = a2 + KSTEP; const unsigned b3 = b2 + KSTEP;
            unsigned o2[2][2];
#pragma unroll
            for (int h = 0; h < 2; ++h)
#pragma unroll
                for (int i = 0; i < 2; ++i) o2[h][i] = last ? on[h][i] : oc[h][i];
            PG8_LDB(B0, 0, 0); PG8_LDB(B1, 0, 1); PG8_SCHED; PG8_LDA(At, 0, 0); PG8_STAGE_A(PG8_SA(1, 1), a1, oc[1]);
            PG8_WAIT_V(8); PG8_WAIT_L(0); PG8_BAR; PG8_MMA(0, 0, At, B0); PG8_MMA(0, 1, At, B1); PG8_BAR; PG8_SCHED;
            PG8_LDA(At, 0, 1); PG8_STAGE_B(PG8_SB(0, 0), b2, 0); PG8_STAGE_B(PG8_SB(0, 1), b2, 1); PG8_STAGE_A(PG8_SA(0, 0), a2, o2[0]);
            PG8_WAIT_V(8); PG8_WAIT_L(0); PG8_BAR; PG8_MMA(1, 0, At, B0); PG8_MMA(1, 1, At, B1); PG8_BAR; PG8_SCHED;
            PG8_LDB(B0, 1, 0); PG8_LDB(B1, 1, 1); PG8_SCHED; PG8_LDA(At, 1, 0); PG8_STAGE_A(PG8_SA(0, 1), a2, o2[1]);
            PG8_WAIT_V(8); PG8_WAIT_L(0); PG8_BAR; PG8_MMA(0, 0, At, B0); PG8_MMA(0, 1, At, B1); PG8_BAR; PG8_SCHED;
            PG8_LDA(At, 1, 1); PG8_STAGE_B(PG8_SB(1, 0), b3, 0); PG8_STAGE_B(PG8_SB(1, 1), b3, 1); PG8_STAGE_A(PG8_SA(1, 0), a3, o2[0]);
            PG8_WAIT_V(8); PG8_WAIT_L(0); PG8_BAR; PG8_MMA(1, 0, At, B0); PG8_MMA(1, 1, At, B1); PG8_BAR; PG8_SCHED;
        }
        if constexpr (Epi::PF_A) {
            if (has_next) { const unsigned row = S.arow(nxt, (nxt.pnl & 3) * 64 + wid * 8 + (lane >> 3));
                for (unsigned c0 = 0; c0 < rowb; c0 += 1024u)
                    __builtin_amdgcn_global_load_lds((const unsigned*)((const unsigned char*)g.A + (size_t)row * rowb + c0 + (lane & 7) * 128), (LAS unsigned*)(lds + PF_JUNK), 4, 0, 0); } }
        if constexpr (ALIGN_EPI) { if (wr == 0) PG8_BAR; }
        if constexpr (F8) asm volatile("s_nop 15\n\ts_nop 7" ::: "memory");
        E(acc, cur, wr, wc, fr, fq);
        if (!has_next) break;
#pragma unroll
        for (int a = 0; a < 2; ++a)
#pragma unroll
            for (int b = 0; b < 2; ++b)
#pragma unroll
                for (int m = 0; m < 4; ++m)
#pragma unroll
                    for (int n = 0; n < 2; ++n) acc[a][b][m][n] = (f32x4){0.f, 0.f, 0.f, 0.f};
        cur = nxt; cB = nB; ++ui;
#pragma unroll
        for (int h = 0; h < 2; ++h)
#pragma unroll
            for (int i = 0; i < 2; ++i) oc[h][i] = on[h][i];
        if constexpr (ALIGN_EPI) { if (wr == 1) PG8_BAR; }
    }
    PG8_WAIT_V(0);
    if constexpr (!ALIGN_EPI) { if (wr == 0) PG8_BAR; }
    PG8_BAR;
#undef PG8_SA
#undef PG8_SB
#undef PG8_STAGE_A
#undef PG8_STAGE_B
#undef PG8_LDA
#undef PG8_LDB
#undef PG8_MMA
#undef PG8_WAIT_V
#undef PG8_WAIT_L
#undef PG8_BAR
#undef PG8_SCHED
#undef PG8_OFFS
}
}

#define XB_TMO      128
#define XB_XCNT(j)  (256  + 64 * (j))
#define XB_XSUB(j)  (1280 + 64 * (j))
#define XB_XGEN(j)  (2304 + 64 * (j))
#define XB_TOP      3328
#define XB_TOPGEN   3392
#define XCD_BAR_WORDS 3456
#define XB_SPIN_CAP (1u << 18)

__device__ __forceinline__ unsigned xb_ld(unsigned* p)              { return __hip_atomic_load(p, __ATOMIC_RELAXED, __HIP_MEMORY_SCOPE_AGENT); }
__device__ __forceinline__ unsigned xb_add(unsigned* p, unsigned v) { return __hip_atomic_fetch_add(p, v, __ATOMIC_RELAXED, __HIP_MEMORY_SCOPE_AGENT); }
__device__ __forceinline__ unsigned xb_xcc_id() { return (unsigned)__builtin_amdgcn_s_getreg((3 << 11) | 20) & 0xFu; }
#define XB_SPIN(cond, bar) do { unsigned _sp = 0; while (cond) { __builtin_amdgcn_s_sleep(1); \
    if ((++_sp & 255u) == 0u) { if (xb_ld(&(bar)[XB_TMO])) break; if (_sp > XB_SPIN_CAP) { atomicAdd(&(bar)[XB_TMO], 1u); break; } } } } while (0)

struct XcdBarrier { unsigned* bar; unsigned x; volatile LAS unsigned* st; };

__device__ __forceinline__ XcdBarrier xcd_barrier_post(unsigned* bar, volatile LAS unsigned* st) {
    XcdBarrier b; b.bar = bar; b.x = xb_xcc_id(); b.st = st;
    if (threadIdx.x == 0) (void)xb_add(&bar[XB_XCNT(b.x)], 1u);
    return b;
}
__device__ __forceinline__ void xcd_barrier_complete(unsigned* bar, unsigned x, unsigned& nloc, unsigned& nx) {
    const unsigned G = gridDim.x * gridDim.y * gridDim.z;
    unsigned sum, cnt, mine, sp = 0u;
    for (;;) {
        sum = 0u; cnt = 0u; mine = 0u;
#pragma unroll
        for (unsigned j = 0; j < 16; ++j) { const unsigned c = xb_ld(&bar[XB_XCNT(j)]); sum += c; cnt += (c > 0u) ? 1u : 0u; mine = (j == x) ? c : mine; }
        if (sum == G) break;
        __builtin_amdgcn_s_sleep(1);
        if ((++sp & 255u) == 0u) { if (xb_ld(&bar[XB_TMO])) break; if (sp > XB_SPIN_CAP) { atomicAdd(&bar[XB_TMO], 1u); break; } }
    }
    nloc = mine > 0u ? mine : 1u; nx = cnt > 0u ? cnt : 1u;
}
__device__ __forceinline__ void xcd_barrier(const XcdBarrier& b) {
    asm volatile("s_waitcnt vmcnt(0)" ::: "memory");
    __syncthreads();
    if (threadIdx.x == 0) {
        unsigned* bar = b.bar;
        __builtin_amdgcn_s_waitcnt(0);
        unsigned nloc = b.st[0], nx = b.st[1];
        if (nloc == 0u) { xcd_barrier_complete(bar, b.x, nloc, nx); b.st[0] = nloc; b.st[1] = nx; }
        const unsigned old = xb_add(&bar[XB_XSUB(b.x)], 1u);
        const unsigned gen = old / nloc;
        if (old + 1u == (gen + 1u) * nloc) {
            __builtin_amdgcn_fence(__ATOMIC_RELEASE, "agent");
            asm volatile("s_waitcnt vmcnt(0)" ::: "memory");
            const unsigned og = xb_add(&bar[XB_TOP], 1u);
            const unsigned tg = og / nx;
            if (og + 1u == (tg + 1u) * nx) xb_add(&bar[XB_TOPGEN], 1u);
            else XB_SPIN(xb_ld(&bar[XB_TOPGEN]) == tg, bar);
            __builtin_amdgcn_fence(__ATOMIC_ACQUIRE, "agent");
            xb_add(&bar[XB_XGEN(b.x)], 1u);
            asm volatile("s_waitcnt vmcnt(0)" ::: "memory");
        } else {
            XB_SPIN(xb_ld(&bar[XB_XGEN(b.x)]) == gen, bar);
            __builtin_amdgcn_fence(__ATOMIC_ACQUIRE, "agent");
            asm volatile("s_waitcnt vmcnt(0)" ::: "memory");
        }
    }
    __syncthreads();
}

struct Args {
    const float *x, *norm1_g, *w_in, *sb_norm_g, *w_pool, *pool_scale, *w_out, *norm2_g, *w_router, *b_router, *w_gate_up, *b_gate_up, *w_down, *b_down, *final_g;
    float* out; unsigned char* ws; int ph_lo, ph_hi;
};

__device__ __forceinline__ void p0_transpose_item(const float* W, int N, bf16_t* WT, int K, int k0, int n0, int drow0, LAS float* scr, int lane, const float* kscale = nullptr) {
#pragma unroll 8
    for (int i = 0; i < 32; ++i) { const int kk = 2 * i + (lane >> 5); const float sk = kscale ? kscale[k0 + kk] : 1.0f; scr[kk * 33 + (lane & 31)] = W[(size_t)(k0 + kk) * N + n0 + (lane & 31)] * sk; }
    asm volatile("s_waitcnt lgkmcnt(0)" ::: "memory");
    const int c = lane & 7;
#pragma unroll
    for (int j = 0; j < 4; ++j) { const int n = (lane >> 3) + 8 * j; const LAS float* s = scr + (8 * c) * 33 + n;
        u32x4 o; o.x = pk2(s[0 * 33], s[1 * 33]); o.y = pk2(s[2 * 33], s[3 * 33]); o.z = pk2(s[4 * 33], s[5 * 33]); o.w = pk2(s[6 * 33], s[7 * 33]);
        *(u32x4*)(WT + (size_t)(drow0 + n) * K + k0 + 8 * c) = o; }
    asm volatile("s_waitcnt lgkmcnt(0)" ::: "memory");
}

__device__ __forceinline__ void p0_transpose_item_f8(const float* W, int N, unsigned char* WT, int K, int k0, int n0, int drow0, LAS float* scr, int lane) {
#pragma unroll 8
    for (int i = 0; i < 32; ++i) { const int kk = 2 * i + (lane >> 5); scr[kk * 33 + (lane & 31)] = W[(size_t)(k0 + kk) * N + n0 + (lane & 31)]; }
    asm volatile("s_waitcnt lgkmcnt(0)" ::: "memory");
    const int c = lane & 3;
#pragma unroll
    for (int j = 0; j < 2; ++j) { const int n = (lane >> 2) + 16 * j; const LAS float* s = scr + (16 * c) * 33 + n;
        u32x4 o;
        o.x = pk4_fp8(s[0 * 33] * W8_SCALE, s[1 * 33] * W8_SCALE, s[2 * 33] * W8_SCALE, s[3 * 33] * W8_SCALE); o.y = pk4_fp8(s[4 * 33] * W8_SCALE, s[5 * 33] * W8_SCALE, s[6 * 33] * W8_SCALE, s[7 * 33] * W8_SCALE);
        o.z = pk4_fp8(s[8 * 33] * W8_SCALE, s[9 * 33] * W8_SCALE, s[10 * 33] * W8_SCALE, s[11 * 33] * W8_SCALE); o.w = pk4_fp8(s[12 * 33] * W8_SCALE, s[13 * 33] * W8_SCALE, s[14 * 33] * W8_SCALE, s[15 * 33] * W8_SCALE);
        *(u32x4*)(WT + (size_t)(drow0 + n) * K + k0 + 16 * c) = o; }
    asm volatile("s_waitcnt lgkmcnt(0)" ::: "memory");
}

struct P0Desc { const float* W; int N; unsigned char* WT; int K; int k0, n0, drow0; int f8; const float* ks; };
__device__ __forceinline__ void p0_item_load(const P0Desc& d, f32x4 (&v)[8], int lane) {
    const float* src = d.W + (size_t)(d.k0 + (lane >> 3)) * d.N + d.n0 + 4 * (lane & 7);
#pragma unroll
    for (int i = 0; i < 8; ++i) v[i] = *(const f32x4*)(src + (size_t)(8 * i) * d.N);
}
__device__ __forceinline__ void p0_item_finish(const P0Desc& d, const f32x4 (&v)[8], LAS float* scr, int lane) {
#pragma unroll
    for (int i = 0; i < 8; ++i) { const int kk = 8 * i + (lane >> 3); const float sk = d.ks ? d.ks[d.k0 + kk] : 1.0f; LAS float* p = scr + kk * 33 + 4 * (lane & 7);
        p[0] = v[i].x * sk; p[1] = v[i].y * sk; p[2] = v[i].z * sk; p[3] = v[i].w * sk; }
    asm volatile("s_waitcnt lgkmcnt(0)" ::: "memory");
    if (d.f8) { const int c = lane & 3;
#pragma unroll
        for (int j = 0; j < 2; ++j) { const int n = (lane >> 2) + 16 * j; const LAS float* s = scr + (16 * c) * 33 + n;
            u32x4 o;
            o.x = pk4_fp8(s[0 * 33] * W8_SCALE, s[1 * 33] * W8_SCALE, s[2 * 33] * W8_SCALE, s[3 * 33] * W8_SCALE); o.y = pk4_fp8(s[4 * 33] * W8_SCALE, s[5 * 33] * W8_SCALE, s[6 * 33] * W8_SCALE, s[7 * 33] * W8_SCALE);
            o.z = pk4_fp8(s[8 * 33] * W8_SCALE, s[9 * 33] * W8_SCALE, s[10 * 33] * W8_SCALE, s[11 * 33] * W8_SCALE); o.w = pk4_fp8(s[12 * 33] * W8_SCALE, s[13 * 33] * W8_SCALE, s[14 * 33] * W8_SCALE, s[15 * 33] * W8_SCALE);
            *(u32x4*)(d.WT + (size_t)(d.drow0 + n) * d.K + d.k0 + 16 * c) = o; }
    } else { const int c = lane & 7;
#pragma unroll
        for (int j = 0; j < 4; ++j) { const int n = (lane >> 3) + 8 * j; const LAS float* s = scr + (8 * c) * 33 + n;
            u32x4 o; o.x = pk2(s[0 * 33], s[1 * 33]); o.y = pk2(s[2 * 33], s[3 * 33]); o.z = pk2(s[4 * 33], s[5 * 33]); o.w = pk2(s[6 * 33], s[7 * 33]);
            *(u32x4*)(d.WT + ((size_t)(d.drow0 + n) * d.K + d.k0 + 8 * c) * 2) = o; }
    }
    asm volatile("s_waitcnt lgkmcnt(0)" ::: "memory");
}

constexpr int ATT_SLOTS = 19;
__device__ __forceinline__ LAS unsigned char* att_slot(LAS unsigned char* lds, int tile) { const int sl = tile % ATT_SLOTS; return lds + sl * 8192 + (sl >= 16 ? 8192 : 0); }
struct AttKvLds { const LAS unsigned char* bp; int kro, ksw, vro, vsw;
    __device__ __forceinline__ bf16x8 k(int s, int hi) const { return *(const LAS bf16x8*)(bp + kro + (((2 * s + hi) ^ ksw) << 4)); }
    __device__ __forceinline__ u32x2 v(int s, int db, int jj) const { return *(const LAS u32x2*)(bp + vro + db * 2048 + (((2 * s + jj) ^ vsw) << 4)); } };
struct AttKvGlb { const bf16_t* kp; const bf16_t* vp;
    __device__ __forceinline__ bf16x8 k(int s, int) const { return *(const bf16x8*)(kp + 16 * s); }
    __device__ __forceinline__ u32x2 v(int s, int db, int jj) const { return *(const u32x2*)(vp + db * 1024 + (2 * s + jj) * 8); } };
struct AttKf { bf16x8 f[4]; };  struct AttVf { u32x2 f[8]; };  struct AttPb { bf16x8 f[2]; };
template <class KV> __device__ __forceinline__ AttKf att_read_k(const KV& kv, int hi) { AttKf k;
#pragma unroll
    for (int s = 0; s < 4; ++s) k.f[s] = kv.k(s, hi);
    return k; }
template <class KV> __device__ __forceinline__ AttVf att_read_v(const KV& kv) { AttVf v;
#pragma unroll
    for (int s = 0; s < 2; ++s) {
#pragma unroll
        for (int db = 0; db < 2; ++db) { v.f[4 * s + 2 * db] = kv.v(s, db, 0); v.f[4 * s + 2 * db + 1] = kv.v(s, db, 1); } }
    return v; }
__device__ __forceinline__ f32x16 att_qk(const AttKf& k, const bf16x8 (&qf)[4]) {
    f32x16 p;
#pragma unroll
    for (int r = 0; r < 16; ++r) p[r] = 0.f;
#pragma unroll
    for (int s = 0; s < 4; ++s) p = __builtin_amdgcn_mfma_f32_32x32x16_bf16(k.f[s], qf[s], p, 0, 0, 0);
    return p; }
template <bool DIAG> __device__ __forceinline__ AttPb att_weights(const f32x16& p, int r32, int hi, float& run) {
    float kp[16];
#pragma unroll
    for (int r = 0; r < 16; ++r) kp[r] = __builtin_amdgcn_rcpf(1.0f + __builtin_amdgcn_exp2f(p[r]));
    if (DIAG) {
#pragma unroll
        for (int r = 0; r < 16; ++r) kp[r] = (crow(r, hi) < r32) ? kp[r] : 1.0f;
    }
    float gs[4], og[4], aft[4];
#pragma unroll
    for (int g = 0; g < 4; ++g) { kp[4 * g + 2] *= kp[4 * g + 3]; kp[4 * g + 1] *= kp[4 * g + 2]; kp[4 * g] *= kp[4 * g + 1]; gs[g] = kp[4 * g]; og[g] = xhalf(gs[g], hi); }
    float acc_after = run;
#pragma unroll
    for (int g = 3; g >= 0; --g) { aft[g] = hi ? acc_after : (acc_after * og[g]); acc_after *= gs[g] * og[g]; }
    run = acc_after;
    float a[16];
#pragma unroll
    for (int g = 0; g < 4; ++g) { float c = aft[g];
#pragma unroll
        for (int i = 3; i >= 0; --i) { const int r = 4 * g + i; const float ci = aft[g] * kp[r]; a[r] = c - ci; c = ci; } }
    AttPb pb;
#pragma unroll
    for (int s = 0; s < 2; ++s) { u32x4 w; w.x = cvt_pk_bf16(a[8 * s + 0], a[8 * s + 1]); w.y = cvt_pk_bf16(a[8 * s + 2], a[8 * s + 3]); w.z = cvt_pk_bf16(a[8 * s + 4], a[8 * s + 5]); w.w = cvt_pk_bf16(a[8 * s + 6], a[8 * s + 7]);
        pb.f[s] = __builtin_bit_cast(bf16x8, w); }
    return pb; }
__device__ __forceinline__ void att_pv(const AttVf& vf, const AttPb& pb, f32x16& o0, f32x16& o1) {
#pragma unroll
    for (int s = 0; s < 2; ++s) {
#pragma unroll
        for (int db = 0; db < 2; ++db) { const u32x2 va = vf.f[4 * s + 2 * db], vb = vf.f[4 * s + 2 * db + 1];
            u32x4 v; v.x = va.x; v.y = va.y; v.z = vb.x; v.w = vb.y;
            if (db == 0) o0 = __builtin_amdgcn_mfma_f32_32x32x16_bf16(__builtin_bit_cast(bf16x8, v), pb.f[s], o0, 0, 0, 0); else o1 = __builtin_amdgcn_mfma_f32_32x32x16_bf16(__builtin_bit_cast(bf16x8, v), pb.f[s], o1, 0, 0, 0); } } }

template <class Mid> __device__ __forceinline__ void attn_block(const bf16_t* __restrict__ PROJ, const bf16_t* __restrict__ VT, bf16_t* __restrict__ MIX, LAS unsigned char* lds, int bt, int wave, int lane, const Mid& mid) {
    const int c = bt & 7, b = (bt >> 3) & 3, h = bt >> 5;
    const int r32 = lane & 31, hi = lane >> 5;
    const size_t rowbase = (size_t)b * SEQ;
    const bf16_t* ksrc[4]; const bf16_t* vsrc[4];
#pragma unroll
    for (int i = 0; i < 4; ++i) { const int row = 8 * i + (lane >> 3), cc = (lane & 7) ^ ((row >> 1) & 7); ksrc[i] = PROJ + (rowbase + row) * NPROJ + SBW + h * HD + cc * 8;
        const int d = 16 * i + (lane >> 2), p = (lane & 3) ^ ((d >> 2) & 3); vsrc[i] = VT + (size_t)(b * NH + h) * (SEQ / 32) * HD * 32 + d * 32 + p * 8; }
#define ATT_DMA_TILE(j_) do { LAS unsigned char* d_ = att_slot(lds, (j_)); _Pragma("unroll") for (int i_ = 0; i_ < 4; ++i_) { \
        __builtin_amdgcn_global_load_lds((const unsigned*)(ksrc[i_] + (size_t)(j_) * 32 * NPROJ), (LAS unsigned*)(d_ + i_ * 1024), 16, 0, 0); \
        __builtin_amdgcn_global_load_lds((const unsigned*)(vsrc[i_] + (size_t)(j_) * (HD * 32)), (LAS unsigned*)(d_ + 4096 + i_ * 1024), 16, 0, 0); } } while (0)
    AttKvLds kl; kl.kro = r32 * 128; kl.ksw = (r32 >> 1) & 7; kl.vro = 4096 + r32 * 64 + hi * 8; kl.vsw = (r32 >> 2) & 3;
    const int a0 = 32 * c + 24;
    asm volatile("s_waitcnt lgkmcnt(0)" ::: "memory"); __builtin_amdgcn_s_barrier();
    for (int k = wave; k < 12; k += NWAVES) { const int j = a0 - 4 + k; if (j >= 0) ATT_DMA_TILE(j); }
    bf16x8 qf[4], qn[4]; u32x2 pend[8]; bf16_t* pend_op = MIX;
    { const bf16_t* qp = PROJ + (rowbase + (a0 + wave) * 32 + r32) * NPROJ + h * HD + hi * 8;
#pragma unroll
      for (int s = 0; s < 4; ++s) qf[s] = *(const bf16x8*)(qp + 16 * s); }
    mid();
#pragma unroll 1
    for (int n = 0; n < 4; ++n) {
        const int a = a0 - 8 * n, qb = a + wave;
        asm volatile("" ::: "memory");
        __builtin_amdgcn_s_waitcnt(0x0070);
        asm volatile("" ::: "memory");
        __builtin_amdgcn_s_barrier();
        asm volatile("" ::: "memory");
        if (n < 3) {
            if (wave < 7) { const int j = a - 5 - wave; if (j >= 0) ATT_DMA_TILE(j); }
            const bf16_t* qp = PROJ + (rowbase + (qb - 8) * 32 + r32) * NPROJ + h * HD + hi * 8;
#pragma unroll
            for (int s = 0; s < 4; ++s) qn[s] = *(const bf16x8*)(qp + 16 * s);
        }
        f32x16 o0, o1;
#pragma unroll
        for (int r = 0; r < 16; ++r) { o0[r] = 0.f; o1[r] = 0.f; }
        float run = 1.f; bool more = true; int j = qb;
        kl.bp = att_slot(lds, j);
        AttKf kf = att_read_k(kl, hi); AttVf vf = att_read_v(kl);
        f32x16 p = att_qk(kf, qf);
        kl.bp = att_slot(lds, j > 0 ? j - 1 : 0); kf = att_read_k(kl, hi);
        AttPb pbp; AttVf vfp;
        {
            const f32x16 pn = att_qk(kf, qf);
            pbp = att_weights<true>(p, r32, hi, run); vfp = vf; p = pn;
            if (wave == 7 && n < 3 && a >= 12) { asm volatile("s_waitcnt lgkmcnt(0)" ::: "memory"); ATT_DMA_TILE(a - 12); }
            if (n > 0) {
#pragma unroll
                for (int g = 0; g < 4; ++g) { *(u32x2*)(pend_op + 8 * g) = pend[2 * g]; *(u32x2*)(pend_op + 32 + 8 * g) = pend[2 * g + 1]; } }
            --j;
            if (__all(run < 1.0e-38f)) more = false;
        }
#pragma unroll 1
        for (int r = 1; r < 5 && more && j >= 0; ++r) {
            kl.bp = att_slot(lds, j); vf = att_read_v(kl);
            kl.bp = att_slot(lds, j > 0 ? j - 1 : 0); kf = att_read_k(kl, hi);
            const f32x16 pn = att_qk(kf, qf);
            att_pv(vfp, pbp, o0, o1);
            pbp = att_weights<false>(p, r32, hi, run); vfp = vf; p = pn;
            --j;
            if (__all(run < 1.0e-38f)) more = false;
        }
        att_pv(vfp, pbp, o0, o1);
#pragma unroll 1
        for (; more && j >= 0; --j) {
            AttKvGlb kg; kg.kp = PROJ + (rowbase + (size_t)j * 32 + r32) * NPROJ + SBW + h * HD + 8 * hi; kg.vp = VT + ((size_t)(b * NH + h) * (SEQ / 32) + j) * (HD * 32) + r32 * 32 + 4 * hi;
            const AttKf kg_k = att_read_k(kg, hi); const AttVf kg_v = att_read_v(kg);
            const f32x16 pg = att_qk(kg_k, qf);
            const AttPb pbg = att_weights<false>(pg, r32, hi, run);
            att_pv(kg_v, pbg, o0, o1);
            if (__all(run < 1.0e-38f)) break;
        }
        float ss = 0.f;
#pragma unroll
        for (int r = 0; r < 16; ++r) ss += o0[r] * o0[r] + o1[r] * o1[r];
        ss += __shfl_xor(ss, 32);
        const float rstd = 1.0f / sqrtf(ss * (1.0f / HD) + NORM_EPS);
        pend_op = MIX + (rowbase + qb * 32 + r32) * D + h * HD + 4 * hi;
#pragma unroll
        for (int g = 0; g < 4; ++g) {
            u32x2 w0, w1;
            w0.x = cvt_pk_bf16(o0[4 * g + 0] * rstd, o0[4 * g + 1] * rstd); w0.y = cvt_pk_bf16(o0[4 * g + 2] * rstd, o0[4 * g + 3] * rstd);
            w1.x = cvt_pk_bf16(o1[4 * g + 0] * rstd, o1[4 * g + 1] * rstd); w1.y = cvt_pk_bf16(o1[4 * g + 2] * rstd, o1[4 * g + 3] * rstd);
            pend[2 * g] = w0; pend[2 * g + 1] = w1;
        }
#pragma unroll
        for (int s = 0; s < 4; ++s) qf[s] = qn[s];
    }
#pragma unroll
    for (int g = 0; g < 4; ++g) { *(u32x2*)(pend_op + 8 * g) = pend[2 * g]; *(u32x2*)(pend_op + 32 + 8 * g) = pend[2 * g + 1]; }
#undef ATT_DMA_TILE
}

template <int g, int NT> __device__ __forceinline__ void pool_tiles_g(const bf16_t* __restrict__ PROJ, bf16_t* __restrict__ MIX, int tile0, int tile1, int lane) {
    constexpr int w = 2 << g, NR = w - 1 + 32;
    unsigned x[NT][NR];
#pragma unroll
    for (int q = 0; q < NT; ++q) { const int tok0 = (q ? tile1 : tile0) * 32; const bool head = (tok0 & (SEQ - 1)) == 0;
        const unsigned* src = (const unsigned*)(PROJ + (size_t)tok0 * NPROJ + 3 * SBW + g * 128) + lane;
#pragma unroll
        for (int i = 0; i < NR; ++i) { const int row = i - (w - 1); x[q][i] = 0u; if (row >= 0 || !head) x[q][i] = src[(long)row * (NPROJ / 2)]; } }
#pragma unroll
    for (int q = 0; q < NT; ++q) { const int tok0 = (q ? tile1 : tile0) * 32; const bool head = (tok0 & (SEQ - 1)) == 0;
        unsigned* dst = (unsigned*)(MIX + (size_t)tok0 * D + SBW + g * 128) + lane;
        float s0 = 0.f, s1 = 0.f;
#pragma unroll
        for (int i = 0; i < w - 1; ++i) { s0 += bflo(x[q][i]); s1 += bfhi(x[q][i]); }
#pragma unroll
        for (int t = 0; t < 32; ++t) { const unsigned xi = x[q][w - 1 + t]; s0 += bflo(xi); s1 += bfhi(xi);
            const float inv = (head && t + 1 < w) ? 1.0f / (float)(t + 1) : 1.0f / (float)w;
            dst[(size_t)t * (D / 2)] = cvt_pk_bf16(s0 * inv - bflo(xi), s1 * inv - bfhi(xi));
            s0 -= bflo(x[q][t]); s1 -= bfhi(x[q][t]); } }
}

template <int NT> __device__ __forceinline__ void pool_tiles(const bf16_t* __restrict__ PROJ, bf16_t* __restrict__ MIX, int task0, int task1, int lane) {
    const int g = task0 & 3, t0 = task0 >> 2, t1 = task1 >> 2;
    if (g == 0) pool_tiles_g<0, NT>(PROJ, MIX, t0, t1, lane); else if (g == 1) pool_tiles_g<1, NT>(PROJ, MIX, t0, t1, lane);
    else if (g == 2) pool_tiles_g<2, NT>(PROJ, MIX, t0, t1, lane); else pool_tiles_g<3, NT>(PROJ, MIX, t0, t1, lane);
}

__device__ __forceinline__ void build_moe_tables(LAS unsigned char* misc, const unsigned* gcnt, int tid) {
    LAS int* l_cnt = (LAS int*)(misc + MO_CNT); LAS int* l_ts = (LAS int*)(misc + MO_TSTART); LAS int* l_T = (LAS int*)(misc + MO_T); LAS int* l_te = (LAS int*)(misc + MO_TILEE);
    if (tid < 64) {
        const int e = tid & 31; const int c = (int)__hip_atomic_load(gcnt + e, RLX_AGENT); const int ntl = (c + 255) >> 8;
        int incl = ntl;
#pragma unroll
        for (int o = 1; o < 32; o <<= 1) { const int v = __shfl_up(incl, o, 32); if (e >= o) incl += v; }
        if (tid < 32) { l_cnt[e] = c; l_ts[e] = incl - ntl; if (e == 31) { l_ts[32] = incl; l_T[0] = incl; } }
    }
    __syncthreads();
    const int T = l_T[0];
    for (int rt = tid; rt < T; rt += NWAVES * 64) { int e = 0;
#pragma unroll 1
        for (int k = 1; k < 32; ++k) if (l_ts[k] <= rt) e = k;
        l_te[rt] = e; }
    __syncthreads();
}

__global__ void __launch_bounds__(NWAVES * 64, 2) mk_fwd(Args args) {
    extern __shared__ __attribute__((aligned(16))) unsigned char lds_raw[];
    LAS unsigned char* lds = (LAS unsigned char*)lds_raw;
    LAS unsigned char* misc = lds + MISC_OFF;
    const int tid = threadIdx.x, lane = tid & 63, wave = __builtin_amdgcn_readfirstlane(tid >> 6);
    const int G = gridDim.x; const int bx = blockIdx.x; const int vcu = (G % 8 == 0) ? (bx % 8) * (G / 8) + bx / 8 : bx;
    unsigned char* ws = args.ws;
    unsigned* ctl = (unsigned*)(ws + WS_CTL);
    bf16_t* Win_t = (bf16_t*)(ws + WS_WIN); bf16_t* Wout_t = (bf16_t*)(ws + WS_WOUT); float* Wr_t = (float*)(ws + WS_WR);
    bf16_t* Wgu_t = (bf16_t*)(ws + WS_WGU); bf16_t* Wd_t = (bf16_t*)(ws + WS_WD);
    float* X1 = (float*)(ws + WS_X1); bf16_t* H2 = (bf16_t*)(ws + WS_H2); int* LTOK = (int*)(ws + WS_LTOK); float* LGATE = (float*)(ws + WS_LGATE); int* TCODE = (int*)(ws + WS_TCODE); float* LRSTD = (float*)(ws + WS_LRSTD); float* RMS = (float*)(ws + WS_LGATE + 1 * MiB); float* WPE = (float*)(ws + WS_LGATE + 2 * MiB);
    bf16_t* HMID = (bf16_t*)(ws + WS_HMID); bf16_t* YB = (bf16_t*)(ws + WS_Y); bf16_t* XN = (bf16_t*)(ws + WS_XN); bf16_t* PROJ = (bf16_t*)(ws + WS_PROJ); bf16_t* MIX = (bf16_t*)(ws + WS_MIX); bf16_t* VT = (bf16_t*)(ws + WS_VT);

    for (int u = tid; u < (LDS_BYTES - MISC_OFF) / 4; u += NWAVES * 64) ((LAS unsigned*)misc)[u] = 0u;
    __syncthreads();
    XcdBarrier bar; bar.bar = ctl + CW_BAR; bar.x = 0; bar.st = nullptr;
    if (MK_N_LAUNCHES == 1) bar = xcd_barrier_post(ctl + CW_BAR, (volatile LAS unsigned*)(misc + MO_BAR));
#define GRID_BAR() do { if (MK_N_LAUNCHES == 1) xcd_barrier(bar); } while (0)
    const int lo = args.ph_lo, hi_ph = args.ph_hi;
#define IN(k) (lo <= (k) && (k) < hi_ph)
#define BOTH(k) (IN(k) && IN((k) + 1))
    const int gw = vcu * NWAVES + wave, NGW = G * NWAVES;

    if (IN(0)) { {
        LAS float* scr = (LAS float*)(lds + wave * 16384);
        constexpr int I_IN = (D / 64) * (NPROJ / 32), I_OUT = (SBW / 64) * (D / 32), I_GU = (D / 64) * (2 * FF / 32), I_DN = (FF / 64) * (D / 32);
        constexpr int NITEMS = I_IN + I_OUT + NE * I_GU + (NE - DEFER_E) * I_DN;
        auto decode = [&](int r, P0Desc& d) {
            d.ks = nullptr; d.f8 = 0;
            if (r < I_IN) { const int nb = NPROJ / 32, kb = r / nb; d.W = args.w_in; d.N = NPROJ; d.WT = (unsigned char*)Win_t; d.K = D; d.k0 = kb * 64; d.n0 = (r % nb) * 32; d.drow0 = d.n0; d.ks = args.norm1_g; return; } r -= I_IN;
            if (r < I_OUT) { const int nb = D / 32, kb = r / nb; d.W = args.w_out; d.N = D; d.WT = (unsigned char*)Wout_t; d.K = D; d.k0 = kb * 64; d.n0 = (r % nb) * 32; d.drow0 = d.n0; d.ks = args.sb_norm_g; return; } r -= I_OUT;
            if (r < NE * I_GU) { const int e = r / I_GU, q = r % I_GU, nb = 2 * FF / 32, kb = q / nb, n0 = (q % nb) * 32; const int j = n0 & (FF - 1);
                d.W = args.w_gate_up + (size_t)e * D * 2 * FF; d.N = 2 * FF; d.WT = (unsigned char*)Wgu_t + (size_t)e * 2 * FF * D * MOE_EB; d.K = D; d.k0 = kb * 64; d.n0 = n0;
                d.drow0 = (j >> 7) * 256 + (n0 >= FF ? 128 : 0) + (j & 127); d.f8 = MOE_FP8; return; } r -= NE * I_GU;
            { const int e = r / I_DN, q = r % I_DN, nb = D / 32, kb = q / nb, n0 = (q % nb) * 32;
                d.W = args.w_down + (size_t)e * FF * D; d.N = D; d.WT = (unsigned char*)Wd_t + (size_t)e * D * FF * MOE_EB; d.K = FF; d.k0 = kb * 64; d.n0 = n0; d.drow0 = n0; d.f8 = MOE_FP8; }
        };
        for (int it = gw; it < NITEMS; it += NGW) { P0Desc dc; f32x4 va[8]; decode(it, dc); p0_item_load(dc, va, lane); p0_item_finish(dc, va, scr, lane); }
        __syncthreads();
        for (int wi = bx; wi < 4 * (D / 16); wi += G) { const int g = wi / (D / 16), n0 = (wi % (D / 16)) * 16;
            LAS float* wps = (LAS float*)lds; LAS float* wos = (LAS float*)(lds + 128 * 129 * 4);
            for (int i = tid; i < 128 * 32; i += NWAVES * 64) { const int cc = i >> 5, d4 = (i & 31) * 4;
                const f32x4 w4 = *(const f32x4*)(args.w_pool + ((size_t)(g * 128 + cc)) * 128 + d4), p4 = *(const f32x4*)(args.pool_scale + g * 128 + d4);
                LAS float* q = wps + cc * 129 + d4; q[0] = w4.x * p4.x; q[1] = w4.y * p4.y; q[2] = w4.z * p4.z; q[3] = w4.w * p4.w; }
            { const int d = tid >> 2, c4 = (tid & 3) * 4; *(LAS f32x4*)(wos + d * 16 + c4) = *(const f32x4*)(args.w_out + (size_t)(SBW + 128 * g + d) * D + n0 + c4); }
            __syncthreads();
            { const int rc = tid & 127, nq = tid >> 7; const LAS float* ap = wps + rc * 129; const LAS float* bp = wos + nq * 4;
              f32x4 a4 = (f32x4){0.f, 0.f, 0.f, 0.f};
#pragma unroll 16
              for (int d = 0; d < 128; ++d) a4 += *(const LAS f32x4*)(bp + d * 16) * ap[d];
              *(f32x4*)(WPE + (size_t)(g * 128 + rc) * D + n0 + nq * 4) = a4; }
            __syncthreads();
        }
        for (int i = bx * (NWAVES * 64) + tid; i < NE * D; i += G * NWAVES * 64) { const int e = i >> 10, k = i & 1023; const float w = args.w_router[k * NE + e];
            const unsigned hb = f2bf(w); const float wl = w - __builtin_bit_cast(float, hb << 16); ((bf16_t*)Wr_t)[i] = (bf16_t)hb; ((bf16_t*)Wr_t)[NE * D + i] = (bf16_t)f2bf(wl); }
        for (int m = gw; m < M; m += NGW) {
            const f32x4* xr = (const f32x4*)(args.x + (size_t)m * D) + lane;
            f32x4 v[4]; float s = 0.f;
#pragma unroll
            for (int j = 0; j < 4; ++j) { v[j] = xr[64 * j]; s += (v[j].x * v[j].x + v[j].y * v[j].y) + (v[j].z * v[j].z + v[j].w * v[j].w); }
            const float rms = sqrtf(wave_sum(s) * (1.0f / D) + NORM_EPS), rstd = 1.0f / rms;
            if (lane == 0) RMS[m] = rms;
            unsigned long long* o8 = (unsigned long long*)(XN + (size_t)m * D) + lane;
#pragma unroll
            for (int j = 0; j < 4; ++j)
                o8[64 * j] = (unsigned long long)pk2(v[j].x * rstd, v[j].y * rstd) | ((unsigned long long)pk2(v[j].z * rstd, v[j].w * rstd) << 32);
        }
}         if (BOTH(0)) GRID_BAR();
    }

    if (IN(1)) { {
        pg8::Gemm g{XN, Win_t, D}; pg8::DenseOrder S{M / 256, NPROJ / 256, G, bx};
        pg8::EpiProj E{PROJ, VT, lds + 3 * pg8::HTB};
        pg8::gemm_phase<pg8::EpiProj, pg8::DenseOrder, true>(lds, g, S, E);
}         if (BOTH(1)) GRID_BAR();
    }

    if (IN(2)) { {
        const int wr32 = lane & 31, whi = lane >> 5;
        for (int bt = vcu, first = 1; bt < BATCH * NH * (SEQ / 1024); bt += G, first = 0) {
            float wv[4] = {0.f, 0.f, 0.f, 0.f}; const int it = gw, k0 = (it >> 5) * 8 + 4 * whi, n = (it & 31) * 32 + wr32;
            const bool wj = first && it < (SBW / 8) * (D / 32);
            if (wj) {
#pragma unroll
                for (int j = 0; j < 4; ++j) wv[j] = WPE[(size_t)(k0 + j) * D + n]; }
            attn_block(PROJ, VT, MIX, lds, bt, wave, lane, [&]() { if (wj) { u32x2 o; o.x = pk2(wv[0], wv[1]); o.y = pk2(wv[2], wv[3]); *(u32x2*)(Wout_t + (size_t)n * D + SBW + k0) = o; } });
        }
        for (int it = gw + NGW; it < (SBW / 8) * (D / 32); it += NGW) { const int k0 = (it >> 5) * 8 + 4 * whi, n = (it & 31) * 32 + wr32;
            u32x2 o; o.x = pk2(WPE[(size_t)k0 * D + n], WPE[(size_t)(k0 + 1) * D + n]); o.y = pk2(WPE[(size_t)(k0 + 2) * D + n], WPE[(size_t)(k0 + 3) * D + n]); *(u32x2*)(Wout_t + (size_t)n * D + SBW + k0) = o; }
        for (int t = gw; t < (M / 32) * 4; t += 2 * NGW) { if (t + NGW < (M / 32) * 4) pool_tiles<2>(PROJ, MIX, t, t + NGW, lane); else pool_tiles<1>(PROJ, MIX, t, t, lane); }
}         if (BOTH(2)) GRID_BAR();
    }

#define P4_FILL_LDS() do { const u32x4* src_ = (const u32x4*)Wr_t;        \
          _Pragma("unroll") for (int q_ = 0; q_ < 16; ++q_) { const int j_ = wave + 8 * q_, row_ = j_ >> 1, p_ = (j_ & 1) * 64 + lane; \
              __builtin_amdgcn_global_load_lds((const unsigned*)(src_ + row_ * 128 + (p_ ^ (row_ & 15))), (LAS unsigned*)(lds + j_ * 1024), 16, 0, 0); } \
          if (wave < 4) __builtin_amdgcn_global_load_lds((const unsigned*)((const f32x4*)args.norm2_g + wave * 64 + lane), (LAS unsigned*)(misc + 16384 + wave * 1024), 16, 0, 0);        \
          asm volatile("s_waitcnt vmcnt(0)" ::: "memory"); } while (0)
    if (IN(3)) { {
        pg8::Gemm g{MIX, Wout_t, D}; pg8::DenseOrder S{M / 256, D / 256, G, bx};
        pg8::EpiRes E{XN, RMS, (bf16_t*)X1};
        pg8::gemm_phase<pg8::EpiRes, pg8::DenseOrder, true>(lds, g, S, E);
        if (MK_N_LAUNCHES == 1 && IN(4)) P4_FILL_LDS();
}         if (BOTH(3)) GRID_BAR();
    }

    if (IN(4)) {
        LAS int* r_e = (LAS int*)(misc + MO_RT);
        LAS float* r_g = (LAS float*)(misc + MO_RT + 2048);
        LAS int* r_lr = (LAS int*)(misc + MO_RT + 4096);
        LAS int* l_cnt = (LAS int*)(misc + MO_RT + 6144);
        LAS int* l_base = (LAS int*)(misc + MO_RT + 6144 + 128);
        LAS float* r_rs = (LAS float*)(misc + MO_RT + 6144 + 256);
        if (MK_N_LAUNCHES != 1 || !IN(3)) P4_FILL_LDS();
        for (int blk = bx; blk < M / 128; blk += G) {
            if (tid < 32) l_cnt[tid] = 0;
            __syncthreads();
            {
                const int t = lane & 15, g = lane >> 4; const int rl = wave * 16 + t; const int tok = blk * 128 + rl;
                const int cg = MOE_FP8 ? 2 * (g & 1) + (g >> 1) : g;
                const bf16_t* xp = (const bf16_t*)X1 + (size_t)tok * D + 8 * cg; const LAS float* gp = (const LAS float*)(misc + 16384) + 8 * cg;
                unsigned char* hp = (unsigned char*)H2 + (size_t)tok * D + 16 * (g & 1) + 32 * (g >> 1);
                const LAS unsigned char* wrow = lds + t * 2048;
                f32x4 acc0 = (f32x4){0.f, 0.f, 0.f, 0.f}, acc1 = acc0; float ss = 0.f;
                u32x4 xq[2][4]; u32x2 h8p = (u32x2){0u, 0u};
#define P4_LOADX(buf, grp) do { _Pragma("unroll") for (int s_ = 0; s_ < 4; ++s_) xq[buf][s_] = *(const u32x4*)(xp + 32 * (4 * (grp) + s_)); } while (0)
#define P4_GROUP(buf, grp) do { _Pragma("unroll") for (int s4 = 0; s4 < 4; ++s4) { const int sgm = 4 * (grp) + s4; \
                    const f32x4 xa = (f32x4){bflo(xq[buf][s4].x), bfhi(xq[buf][s4].x), bflo(xq[buf][s4].y), bfhi(xq[buf][s4].y)}, xb = (f32x4){bflo(xq[buf][s4].z), bfhi(xq[buf][s4].z), bflo(xq[buf][s4].w), bfhi(xq[buf][s4].w)}; \
                    const f32x4 ga = *(const LAS f32x4*)(gp + 32 * sgm), gb = *(const LAS f32x4*)(gp + 32 * sgm + 4); \
                    const int wco = ((4 * sgm + cg) ^ t) << 4; \
                    const bf16x8 a_h0 = *(const LAS bf16x8*)(wrow + wco), a_h1 = *(const LAS bf16x8*)(wrow + 32768 + wco), a_l0 = *(const LAS bf16x8*)(wrow + 65536 + wco), a_l1 = *(const LAS bf16x8*)(wrow + 98304 + wco); \
                    ss += (xa.x * xa.x + xa.y * xa.y) + (xa.z * xa.z + xa.w * xa.w) + (xb.x * xb.x + xb.y * xb.y) + (xb.z * xb.z + xb.w * xb.w); \
                    const f32x4 ya = xa * ga, yb = xb * gb; \
                    u32x2 h8; h8.x = pk4_fp8(ya.x, ya.y, ya.z, ya.w); h8.y = pk4_fp8(yb.x, yb.y, yb.z, yb.w); \
                    if (MOE_FP8) { if (s4 & 1) { const auto r0_ = __builtin_amdgcn_permlane32_swap(h8p.x, h8.x, false, false), r1_ = __builtin_amdgcn_permlane32_swap(h8p.y, h8.y, false, false); \
                        u32x4 o_; o_.x = r0_[0]; o_.y = r1_[0]; o_.z = r0_[1]; o_.w = r1_[1]; *(u32x4*)(hp + 32 * (sgm - 1)) = o_; } else h8p = h8; } \
                    u32x4 yh; yh.x = cvt_pk_bf16(ya.x, ya.y); yh.y = cvt_pk_bf16(ya.z, ya.w); yh.z = cvt_pk_bf16(yb.x, yb.y); yh.w = cvt_pk_bf16(yb.z, yb.w); \
                    if (!MOE_FP8) *(u32x4*)((bf16_t*)H2 + (size_t)tok * D + 8 * g + 32 * sgm) = yh; \
                    u32x4 yl; yl.x = cvt_pk_bf16(ya.x - bflo(yh.x), ya.y - bfhi(yh.x)); yl.y = cvt_pk_bf16(ya.z - bflo(yh.y), ya.w - bfhi(yh.y)); \
                    yl.z = cvt_pk_bf16(yb.x - bflo(yh.z), yb.y - bfhi(yh.z)); yl.w = cvt_pk_bf16(yb.z - bflo(yh.w), yb.w - bfhi(yh.w)); \
                    const bf16x8 b_h = __builtin_bit_cast(bf16x8, yh), b_l = __builtin_bit_cast(bf16x8, yl); \
                    acc0 = __builtin_amdgcn_mfma_f32_16x16x32_bf16(a_h0, b_h, acc0, 0, 0, 0); acc1 = __builtin_amdgcn_mfma_f32_16x16x32_bf16(a_h1, b_h, acc1, 0, 0, 0); \
                    acc0 = __builtin_amdgcn_mfma_f32_16x16x32_bf16(a_h0, b_l, acc0, 0, 0, 0); acc1 = __builtin_amdgcn_mfma_f32_16x16x32_bf16(a_h1, b_l, acc1, 0, 0, 0); \
                    acc0 = __builtin_amdgcn_mfma_f32_16x16x32_bf16(a_l0, b_h, acc0, 0, 0, 0); acc1 = __builtin_amdgcn_mfma_f32_16x16x32_bf16(a_l1, b_h, acc1, 0, 0, 0); \
                    asm volatile("" : "+v"(acc0), "+v"(acc1), "+v"(ss)); } } while (0)
                P4_LOADX(0, 0);
#pragma unroll 1
                for (int g2i = 0; g2i < 4; ++g2i) {
                    P4_LOADX(1, 2 * g2i + 1); asm volatile("" ::: "memory");
                    P4_GROUP(0, 2 * g2i);
                    if (g2i < 3) P4_LOADX(0, 2 * g2i + 2);
                    asm volatile("" ::: "memory");
                    P4_GROUP(1, 2 * g2i + 1);
                }
#undef P4_GROUP
#undef P4_LOADX
                ss += __shfl_xor(ss, 16); ss += __shfl_xor(ss, 32);
                const float rstd = 1.0f / sqrtf(ss * (1.0f / D) + NORM_EPS);
                unsigned key[8];
#pragma unroll
                for (int i = 0; i < 8; ++i) { const int e = (i < 4) ? 4 * g + i : 16 + 4 * g + (i - 4); const float lg = ((i < 4) ? acc0[i & 3] : acc1[i & 3]) * rstd + args.b_router[e];
                    const unsigned ub = __builtin_bit_cast(unsigned, lg); const unsigned od = ub ^ ((ub >> 31) ? 0xffffffffu : 0x80000000u); key[i] = (od & ~31u) | (unsigned)(31 - e); }
                unsigned v0 = 0u, v1 = 0u, v2 = 0u, v3 = 0u;
#define TOP_INS(x) do { unsigned x_ = (x), lo_; lo_ = min(v0, x_); v0 = max(v0, x_); x_ = lo_; lo_ = min(v1, x_); v1 = max(v1, x_); x_ = lo_; lo_ = min(v2, x_); v2 = max(v2, x_); x_ = lo_; v3 = max(v3, x_); } while (0)
#pragma unroll
                for (int i = 0; i < 8; ++i) TOP_INS(key[i]);
#pragma unroll
                for (int o = 16; o <= 32; o <<= 1) { const unsigned p0 = __shfl_xor(v0, o), p1 = __shfl_xor(v1, o), p2 = __shfl_xor(v2, o), p3 = __shfl_xor(v3, o); TOP_INS(p0); TOP_INS(p1); TOP_INS(p2); TOP_INS(p3); }
#undef TOP_INS
                float sv[4]; int se[4]; const unsigned vv[4] = {v0, v1, v2, v3};
#pragma unroll
                for (int k = 0; k < 4; ++k) { se[k] = 31 - (int)(vv[k] & 31u); const unsigned od = vv[k] & ~31u; const unsigned ub = (od & 0x80000000u) ? (od ^ 0x80000000u) : ~od; sv[k] = __builtin_bit_cast(float, ub); }
                const float e1 = __expf(sv[1] - sv[0]), e2 = __expf(sv[2] - sv[0]), e3 = __expf(sv[3] - sv[0]); const float rsum = 1.0f / (1.0f + e1 + e2 + e3);
                { const int myE = g == 0 ? se[0] : g == 1 ? se[1] : g == 2 ? se[2] : se[3]; const float myG = (g == 0 ? 1.0f : g == 1 ? e1 : g == 2 ? e2 : e3) * rsum;
                  const int lr = __hip_atomic_fetch_add(l_cnt + myE, 1, __ATOMIC_RELAXED, __HIP_MEMORY_SCOPE_WORKGROUP);
                  r_e[rl * 4 + g] = myE; r_g[rl * 4 + g] = myG; r_lr[rl * 4 + g] = lr; if (g == 0) r_rs[rl] = rstd; }
            }
            __syncthreads();
            if (tid < 32) l_base[tid] = (int)__hip_atomic_fetch_add(ctl + CW_CNT + tid, (unsigned)l_cnt[tid], RLX_AGENT);
            __syncthreads();
            { const int rl = tid >> 2, k = tid & 3; const int e = r_e[tid]; const int rank = l_base[e] + r_lr[tid]; const int tok = blk * 128 + rl;
              LTOK[(size_t)e * LISTCAP + rank] = tok; LGATE[tok * 4 + k] = r_g[tid]; LRSTD[(size_t)e * LISTCAP + rank] = r_rs[rl]; TCODE[tok * 4 + k] = rank * 32 + e; }
            __syncthreads();
        }
        if (BOTH(4)) GRID_BAR();
    }

    if (IN(5)) { {
        build_moe_tables(misc, ctl + CW_CNT, tid);
        const int T = ((LAS int*)(misc + MO_T))[0];
        pg8::Gemm g{H2, Wgu_t, D * MOE_EB / 2};
        pg8::MoeOrder<true> S{T, 2 * FF / 256, G, bx, (const LAS int*)(misc + MO_TILEE), (const LAS int*)(misc + MO_TSTART), (const LAS int*)(misc + MO_CNT), LTOK, (const LAS unsigned short*)(misc + MO_IDS), (const LAS int*)(misc + MO_UT)};
        S.post((LAS int*)(misc + MO_UT), tid); __syncthreads();
        pg8::EpiSwiglu E{HMID, args.b_gate_up, LRSTD, (const LAS float*)(misc + MO_RS), misc + MO_BIAS};
        { LAS unsigned short* ids = (LAS unsigned short*)(misc + MO_IDS); LAS float* rsl = (LAS float*)(misc + MO_RS); pg8::Unit u;
          unsigned val[MAXU]; const int r = tid & 255; const unsigned* src = (tid < 256) ? (const unsigned*)LTOK : (const unsigned*)LRSTD;
#pragma unroll
          for (int i = 0; i < MAXU; ++i) { val[i] = 0u; if (S.next(i, u)) { const int rk = u.rank0 + r; if (rk < u.cnt) val[i] = src[(size_t)u.e * LISTCAP + rk]; } }
#pragma unroll
          for (int i = 0; i < MAXU; ++i) { if (tid < 256) ids[i * 256 + r] = (unsigned short)val[i]; else rsl[i * 256 + r] = __builtin_bit_cast(float, val[i]); }
          __syncthreads(); }
        pg8::gemm_phase<pg8::EpiSwiglu, pg8::MoeOrder<true>, true, MOE_FP8 != 0>(lds, g, S, E);
        if (DEFER_E > 0) {
            constexpr int I_DNT = (FF / 64) * (D / 32);
            const int nun = T * (2 * FF / 256), rem = nun % G; int idx = -1, cntw = 1;
            if (rem == 0 || G - rem < (3 * G) / 8) { idx = bx; cntw = G; } else if (bx >= rem) { idx = bx - rem; cntw = G - rem; }
            if (idx >= 0) { LAS float* scr = (LAS float*)(lds + wave * 16384);
                for (int it = idx * NWAVES + wave; it < DEFER_E * I_DNT; it += cntw * NWAVES) { const int e = NE - DEFER_E + it / I_DNT, q = it % I_DNT, nb = D / 32, kb = q / nb, n0 = (q % nb) * 32;
                    P0Desc d; d.W = args.w_down + (size_t)e * FF * D; d.N = D; d.WT = (unsigned char*)Wd_t + (size_t)e * D * FF * MOE_EB; d.K = FF; d.k0 = kb * 64; d.n0 = n0; d.drow0 = n0; d.f8 = MOE_FP8; d.ks = nullptr;
                    f32x4 va[8]; p0_item_load(d, va, lane); p0_item_finish(d, va, scr, lane); } }
        }
}         if (BOTH(5)) GRID_BAR();
    }

    if (IN(6)) { {
        if (MK_N_LAUNCHES != 1 || !IN(5)) build_moe_tables(misc, ctl + CW_CNT, tid);
        const int T = ((LAS int*)(misc + MO_T))[0];
        pg8::Gemm g{HMID, Wd_t, FF * MOE_EB / 2};
        pg8::MoeOrder<false> S{T, D / 256, G, bx, (const LAS int*)(misc + MO_TILEE), (const LAS int*)(misc + MO_TSTART), (const LAS int*)(misc + MO_CNT), LTOK, (const LAS unsigned short*)(misc + MO_IDS), (const LAS int*)(misc + MO_UT)};
        __syncthreads(); S.post((LAS int*)(misc + MO_UT), tid); __syncthreads();
        pg8::EpiDown E{(unsigned char*)YB, args.b_down, misc + MO_BIAS};
        pg8::gemm_phase<pg8::EpiDown, pg8::MoeOrder<false>, true, MOE_FP8 != 0>(lds, g, S, E);
}         if (BOTH(6)) GRID_BAR();
    }

    if (IN(7)) { {
        if (MK_N_LAUNCHES != 1 || !IN(5)) build_moe_tables(misc, ctl + CW_CNT, tid);
        const LAS int* l_ts = (const LAS int*)(misc + MO_TSTART);
        int code[4][4], ncode[4][4]; float gt[4][4], ngt[4][4];
#define P7_CODES(C, G, m0_) do { _Pragma("unroll") for (int q = 0; q < 4; ++q) { const int m_ = (m0_) + q * NGW; const int mm_ = m_ < M ? m_ : M - 1; \
            _Pragma("unroll") for (int k = 0; k < 4; ++k) { C[q][k] = TCODE[mm_ * 4 + k]; G[q][k] = LGATE[mm_ * 4 + k] * (1.0f / pg8::Y8_SCALE); } } } while (0)
        P7_CODES(code, gt, gw);
        f32x4 fgain[4];
#pragma unroll
        for (int j = 0; j < 4; ++j) fgain[j] = ((const f32x4*)args.final_g + lane)[64 * j];
        for (int m0 = gw; m0 < M; m0 += 4 * NGW) {
            f32x4 v[4][4]; unsigned y[4][4][4];
            P7_CODES(ncode, ngt, (m0 + 4 * NGW < M ? m0 + 4 * NGW : m0));
#pragma unroll
            for (int q = 0; q < 4; ++q) { const int m = m0 + q * NGW; const int mm = m < M ? m : M - 1; const u32x2* xr = (const u32x2*)((const bf16_t*)X1 + (size_t)mm * D) + lane;
#pragma unroll
                for (int j = 0; j < 4; ++j) { const u32x2 xb = xr[64 * j]; v[q][j] = (f32x4){bflo(xb.x), bfhi(xb.x), bflo(xb.y), bfhi(xb.y)}; } }
#pragma unroll
            for (int q = 0; q < 4; ++q)
#pragma unroll
                for (int k = 0; k < 4; ++k) { const int e = code[q][k] & 31, rank = code[q][k] >> 5; const size_t pos = (size_t)l_ts[e] * 256 + rank; const unsigned* yr = (const unsigned*)((const unsigned char*)YB + pos * D) + lane;
#pragma unroll
                    for (int j = 0; j < 4; ++j) y[q][k][j] = yr[64 * j]; }
#pragma unroll
            for (int q = 0; q < 4; ++q) { const int m = m0 + q * NGW; if (m >= M) continue;
#pragma unroll
                for (int k = 0; k < 4; ++k)
#pragma unroll
                    for (int j = 0; j < 4; ++j) { const f32x2 lo = __builtin_amdgcn_cvt_pk_f32_fp8((int)y[q][k][j], false), hi = __builtin_amdgcn_cvt_pk_f32_fp8((int)y[q][k][j], true);
                        v[q][j].x += gt[q][k] * lo.x; v[q][j].y += gt[q][k] * lo.y; v[q][j].z += gt[q][k] * hi.x; v[q][j].w += gt[q][k] * hi.y; }
                float sq = 0.f;
#pragma unroll
                for (int j = 0; j < 4; ++j) sq += (v[q][j].x * v[q][j].x + v[q][j].y * v[q][j].y) + (v[q][j].z * v[q][j].z + v[q][j].w * v[q][j].w);
                const float rstd = 1.0f / sqrtf(wave_sum(sq) * (1.0f / D) + NORM_EPS);
                f32x4* orow = (f32x4*)(args.out + (size_t)m * D) + lane;
#pragma unroll
                for (int j = 0; j < 4; ++j) { const f32x4 gg = fgain[j]; orow[64 * j] = (f32x4){v[q][j].x * rstd * gg.x, v[q][j].y * rstd * gg.y, v[q][j].z * rstd * gg.z, v[q][j].w * rstd * gg.w}; }
            }
#pragma unroll
            for (int q = 0; q < 4; ++q)
#pragma unroll
                for (int k = 0; k < 4; ++k) { code[q][k] = ncode[q][k]; gt[q][k] = ngt[q][k]; }
        }
#undef P7_CODES
    } }
#undef IN
#undef BOTH
#undef GRID_BAR
}

extern "C" void kernel_launch(void* const* d_in, const int* in_sizes, int n_in, void* d_out, int out_size, void* d_ws, size_t ws_size, hipStream_t stream) {
    static int grid = 0;
    if (grid == 0) {
        if (n_in != 15 || in_sizes[0] != M * D || out_size != M * D || ws_size < WS_END) { fprintf(stderr, "kernel_launch: unexpected shapes (n_in %d, in0 %d, out %d, ws %zu)\n", n_in, n_in > 0 ? in_sizes[0] : -1, out_size, ws_size); grid = -1; return; }
        int dev = 0, cus = 0, per_cu = 0;
        if (hipGetDevice(&dev) != hipSuccess || hipDeviceGetAttribute(&cus, hipDeviceAttributeMultiprocessorCount, dev) != hipSuccess) { grid = -1; return; }
        if (hipFuncSetAttribute((const void*)mk_fwd, hipFuncAttributeMaxDynamicSharedMemorySize, LDS_BYTES) != hipSuccess) { fprintf(stderr, "kernel_launch: hipFuncSetAttribute failed\n"); grid = -1; return; }
        if (hipOccupancyMaxActiveBlocksPerMultiprocessor(&per_cu, (const void*)mk_fwd, NWAVES * 64, LDS_BYTES) != hipSuccess || per_cu < 1) { fprintf(stderr, "kernel_launch: occupancy query reports %d\n", per_cu); per_cu = 1; }
        (void)hipGetLastError();
        grid = cus;
    }
    if (grid < 0) return;
    if (hipMemsetAsync((char*)d_ws + WS_CTL, 0, CTL_ZERO_BYTES, stream) != hipSuccess) return;
    Args a{};
    a.x = (const float*)d_in[0]; a.norm1_g = (const float*)d_in[1]; a.w_in = (const float*)d_in[2]; a.sb_norm_g = (const float*)d_in[3]; a.w_pool = (const float*)d_in[4];
    a.pool_scale = (const float*)d_in[5]; a.w_out = (const float*)d_in[6]; a.norm2_g = (const float*)d_in[7]; a.w_router = (const float*)d_in[8]; a.b_router = (const float*)d_in[9];
    a.w_gate_up = (const float*)d_in[10]; a.b_gate_up = (const float*)d_in[11]; a.w_down = (const float*)d_in[12]; a.b_down = (const float*)d_in[13]; a.final_g = (const float*)d_in[14];
    a.out = (float*)d_out; a.ws = (unsigned char*)d_ws;
    if (MK_N_LAUNCHES == 1) { a.ph_lo = 0; a.ph_hi = PER_PHASE; hipLaunchKernelGGL(mk_fwd, dim3(grid), dim3(NWAVES * 64), LDS_BYTES, stream, a); }
    else for (int p = 0; p < PER_PHASE; ++p) { a.ph_lo = p; a.ph_hi = p + 1; hipLaunchKernelGGL(mk_fwd, dim3(grid), dim3(NWAVES * 64), LDS_BYTES, stream, a); }
}
```
